# Optimizing an MI355X kernel written in HIP

```python
import jax, jax.numpy as jnp
from jax import lax
import numpy as np

D_MODEL = 2048
BATCH = 4
SEQ = 4096
DEPTH = 4

N_HEADS = 16
HEAD_DIM = 128
NSA_KV_HEADS = 4
CMP_BLOCK = 32
CMP_STRIDE = 16
CMP_HIDDEN = 256
SEL_BLOCK = 64
SEL_TOPK = 16
WINDOW = 512
NSA_Q_CHUNK = 32
SB_Q_BLOCK = 128
D_FF = 5632
ROPE_THETA = 10000.0
EPS = 1e-6
N_A_LAYERS = DEPTH // 2
N_B_LAYERS = DEPTH - N_A_LAYERS
NSA_IN_DIM = N_HEADS * HEAD_DIM + 6 * NSA_KV_HEADS * HEAD_DIM + 3 * N_HEADS
NEG = -1e30
FORCE = 1e9

kernel_name = "yoco_nsa_stickbreaking_hybrid"


def rms_norm(x, g):
    xf = x.astype(jnp.float32)
    y = xf * lax.rsqrt(jnp.mean(xf * xf, axis=-1, keepdims=True) + EPS)
    return (y * g.astype(jnp.float32)).astype(x.dtype)


def modulate(h, shift, scale):
    return h * (1 + scale[:, None, :]) + shift[:, None, :]


def rope(x, pos):
    half = HEAD_DIM // 2
    inv = ROPE_THETA ** (-jnp.arange(half, dtype=jnp.float32) / half)
    ang = pos.astype(jnp.float32)[:, None] * inv[None, :]
    cos = jnp.cos(ang)[None, :, None, :]
    sin = jnp.sin(ang)[None, :, None, :]
    xf = x.astype(jnp.float32)
    x1, x2 = xf[..., :half], xf[..., half:]
    return jnp.concatenate([x1 * cos - x2 * sin, x2 * cos + x1 * sin], axis=-1).astype(x.dtype)


def compress(kv, pe, w1, w2):
    B, S, G, Dh = kv.shape
    nc = (S - CMP_BLOCK) // CMP_STRIDE + 1
    idx = np.arange(nc)[:, None] * CMP_STRIDE + np.arange(CMP_BLOCK)[None, :]
    blocks = kv[:, idx] + pe[None, None, :, None, :]
    flat = blocks.transpose(0, 1, 3, 2, 4).reshape(B, nc, G, CMP_BLOCK * Dh)
    return jax.nn.gelu(flat @ w1) @ w2


def nsa_attention(q, kc, vc, ks, vs, kw, vw, gates):
    B, S, H, Dh = q.shape
    G = NSA_KV_HEADS
    R = H // G
    nc = kc.shape[1]
    nb = S // SEL_BLOCK
    n_sel = min(SEL_TOPK, nb)
    QC = NSA_Q_CHUNK
    scale = HEAD_DIM ** -0.5
    qg = q.reshape(B, S, G, R, Dh)
    gg = gates.reshape(B, S, G, R, 3)
    cmp_end = jnp.arange(nc) * CMP_STRIDE + CMP_BLOCK - 1
    c_start = np.arange(nc)[:, None] * CMP_STRIDE
    s_start = np.arange(nb)[None, :] * SEL_BLOCK
    overlap = jnp.asarray(((c_start < s_start + SEL_BLOCK) & (c_start + CMP_BLOCK > s_start)).astype(np.float32))
    blk_ids = jnp.arange(nb)
    ks_blk = ks.reshape(B, nb, SEL_BLOCK, G, Dh).transpose(0, 3, 1, 2, 4)
    vs_blk = vs.reshape(B, nb, SEL_BLOCK, G, Dh).transpose(0, 3, 1, 2, 4)
    kw_pad = jnp.pad(kw, ((0, 0), (WINDOW, 0), (0, 0), (0, 0)))
    vw_pad = jnp.pad(vw, ((0, 0), (WINDOW, 0), (0, 0), (0, 0)))
    vc32 = vc.astype(jnp.float32)
    bi = jnp.arange(B)[:, None, None, None]
    gi = jnp.arange(G)[None, :, None, None]

    def chunk(ci):
        start = ci * QC
        qc = lax.dynamic_slice_in_dim(qg, start, QC, axis=1)
        gc = lax.dynamic_slice_in_dim(gg, start, QC, axis=1).astype(jnp.float32)
        t = start + jnp.arange(QC)
        s = jnp.einsum('bqgrd,bngd->bgrqn', qc, kc).astype(jnp.float32) * scale
        valid = cmp_end[None, :] <= t[:, None]
        p_c = jax.nn.softmax(jnp.where(valid, s, NEG), axis=-1) * jnp.any(valid, axis=-1)[:, None].astype(jnp.float32)
        o_c = jnp.einsum('bgrqn,bngd->bqgrd', p_c, vc32)
        imp = jnp.einsum('bgrqn,nm->bgqm', p_c, overlap)
        cur = t // SEL_BLOCK
        forced = (blk_ids[None, :] == 0) | (blk_ids[None, :] == cur[:, None]) | (blk_ids[None, :] == cur[:, None] - 1)
        avail = blk_ids[None, :] * SEL_BLOCK <= t[:, None]
        imp = jnp.where(forced, FORCE, jnp.where(avail, imp, -FORCE))
        _, sel = lax.top_k(imp, n_sel)
        k_sel = ks_blk[bi, gi, sel]
        v_sel = vs_blk[bi, gi, sel].astype(jnp.float32)
        tok = sel[..., None] * SEL_BLOCK + jnp.arange(SEL_BLOCK)
        m_s = tok <= t[None, None, :, None, None]
        s = jnp.einsum('bqgrd,bgqnld->bgrqnl', qc, k_sel).astype(jnp.float32) * scale
        s = jnp.where(m_s[:, :, None], s, NEG).reshape(B, G, R, QC, n_sel * SEL_BLOCK)
        p_s = jax.nn.softmax(s, axis=-1).reshape(B, G, R, QC, n_sel, SEL_BLOCK)
        o_s = jnp.einsum('bgrqnl,bgqnld->bqgrd', p_s, v_sel)
        kwin = lax.dynamic_slice_in_dim(kw_pad, start, WINDOW + QC, axis=1)
        vwin = lax.dynamic_slice_in_dim(vw_pad, start, WINDOW + QC, axis=1).astype(jnp.float32)
        kpos = start - WINDOW + jnp.arange(WINDOW + QC)
        m_w = (kpos[None, :] <= t[:, None]) & (kpos[None, :] > t[:, None] - WINDOW) & (kpos[None, :] >= 0)
        s = jnp.einsum('bqgrd,bkgd->bgrqk', qc, kwin).astype(jnp.float32) * scale
        p_w = jax.nn.softmax(jnp.where(m_w, s, NEG), axis=-1)
        o_w = jnp.einsum('bgrqk,bkgd->bqgrd', p_w, vwin)
        return gc[..., 0:1] * o_c + gc[..., 1:2] * o_s + gc[..., 2:3] * o_w

    out = lax.map(chunk, jnp.arange(S // QC))
    return out.transpose(1, 0, 2, 3, 4, 5).reshape(B, S, H, Dh)


def nsa_mixer(h, pos, w_in, gate_b, cmp_pe, cmp_w1, cmp_w2, w_out):
    B, S, _ = h.shape
    proj = h @ w_in
    sizes = [N_HEADS * HEAD_DIM] + [NSA_KV_HEADS * HEAD_DIM] * 6
    q, kc, vc, ks, vs, kw, vw, g = jnp.split(proj, np.cumsum(sizes).tolist(), axis=-1)
    kv_shape = (B, S, NSA_KV_HEADS, HEAD_DIM)
    q = rope(q.reshape(B, S, N_HEADS, HEAD_DIM), pos)
    kc = rope(kc.reshape(kv_shape), pos)
    ks = rope(ks.reshape(kv_shape), pos)
    kw = rope(kw.reshape(kv_shape), pos)
    vc, vs, vw = vc.reshape(kv_shape), vs.reshape(kv_shape), vw.reshape(kv_shape)
    gates = jax.nn.sigmoid((g + gate_b).astype(jnp.float32)).reshape(B, S, N_HEADS, 3)
    kc = compress(kc, cmp_pe[0], cmp_w1[0], cmp_w2[0])
    vc = compress(vc, cmp_pe[1], cmp_w1[1], cmp_w2[1])
    o = nsa_attention(q, kc, vc, ks, vs, kw, vw, gates)
    return o.reshape(B, S, N_HEADS * HEAD_DIM).astype(h.dtype) @ w_out


def stick_breaking_attention(q, k, v):
    B, S, H, Dh = q.shape
    scale = HEAD_DIM ** -0.5
    kpos = jnp.arange(S)
    v32 = v.astype(jnp.float32)

    def block(bi):
        start = bi * SB_Q_BLOCK
        qb = lax.dynamic_slice_in_dim(q, start, SB_Q_BLOCK, axis=1)
        t = start + jnp.arange(SB_Q_BLOCK)
        z = jnp.einsum('bqhd,bkhd->bhqk', qb, k).astype(jnp.float32) * scale
        causal = kpos[None, :] < t[:, None]
        sp = jnp.where(causal, jax.nn.softplus(z), 0.0)
        after = lax.cumsum(sp, axis=3, reverse=True) - sp
        log_a = jax.nn.log_sigmoid(z) - after
        a = jnp.where(causal, jnp.exp(log_a), 0.0)
        return jnp.einsum('bhqk,bkhd->bqhd', a, v32)

    out = lax.map(block, jnp.arange(S // SB_Q_BLOCK))
    return out.transpose(1, 0, 2, 3, 4).reshape(B, S, H, Dh)


def sb_mixer(h, k, v, w_q, w_out):
    B, S, _ = h.shape
    q = (h @ w_q).reshape(B, S, N_HEADS, HEAD_DIM)
    o = stick_breaking_attention(q, k, v)
    return o.reshape(B, S, N_HEADS * HEAD_DIM).astype(h.dtype) @ w_out


def swiglu(h, w_in, w_out):
    gate, up = jnp.split(h @ w_in, 2, axis=-1)
    return (jax.nn.silu(gate) * up) @ w_out


def setup_inputs(seed: int = 0) -> dict:
    key = jax.random.key(seed)
    ks = jax.random.split(key, 19)
    D = D_MODEL
    f32 = jnp.float32

    def nrm(k, shape, fan_in, gain=1.0):
        return jax.random.normal(k, shape, f32) * (gain * fan_in ** -0.5)

    return {
        "x": jax.random.normal(ks[0], (BATCH, SEQ, D), f32),
        "c": jax.random.normal(ks[1], (BATCH, D), f32),
        "mod_w": nrm(ks[2], (DEPTH, D, 6 * D), D, 0.5),
        "mod_b": 0.02 * jax.random.normal(ks[3], (DEPTH, 6 * D), f32),
        "norm_g": 1.0 + 0.05 * jax.random.normal(ks[4], (DEPTH, 4, D), f32),
        "ffn_w_in": nrm(ks[5], (DEPTH, D, 2 * D_FF), D),
        "ffn_w_out": nrm(ks[6], (DEPTH, D_FF, D), D_FF),
        "a_w_in": nrm(ks[7], (N_A_LAYERS, D, NSA_IN_DIM), D),
        "a_gate_b": 0.02 * jax.random.normal(ks[8], (N_A_LAYERS, 3 * N_HEADS), f32),
        "a_cmp_pe": 0.5 * jax.random.normal(ks[9], (N_A_LAYERS, 2, CMP_BLOCK, HEAD_DIM), f32),
        "a_cmp_w1": nrm(ks[10], (N_A_LAYERS, 2, CMP_BLOCK * HEAD_DIM, CMP_HIDDEN), CMP_BLOCK * HEAD_DIM),
        "a_cmp_w2": nrm(ks[11], (N_A_LAYERS, 2, CMP_HIDDEN, HEAD_DIM), CMP_HIDDEN),
        "a_w_out": nrm(ks[12], (N_A_LAYERS, N_HEADS * HEAD_DIM, D), N_HEADS * HEAD_DIM),
        "b_w_q": nrm(ks[13], (N_B_LAYERS, D, N_HEADS * HEAD_DIM), D),
        "b_w_out": nrm(ks[14], (N_B_LAYERS, N_HEADS * HEAD_DIM, D), N_HEADS * HEAD_DIM),
        "kv_norm_g": 1.0 + 0.05 * jax.random.normal(ks[15], (D,), f32),
        "kv_mod_w": nrm(ks[16], (D, 2 * D), D, 0.5),
        "kv_mod_b": 0.02 * jax.random.normal(ks[17], (2 * D,), f32),
        "kv_w": nrm(ks[18], (D, 2 * N_HEADS * HEAD_DIM), D),
    }


def reference(x, c, mod_w, mod_b, norm_g, ffn_w_in, ffn_w_out, a_w_in, a_gate_b, a_cmp_pe, a_cmp_w1, a_cmp_w2, a_w_out, b_w_q, b_w_out, kv_norm_g, kv_mod_w, kv_mod_b, kv_w):
    B, S, _ = x.shape
    pos = jnp.arange(S)
    c_act = jax.nn.silu(c)
    k_sh = None
    v_sh = None
    for layer in range(DEPTH):
        mod = c_act @ mod_w[layer] + mod_b[layer]
        sh1, sc1, g1, sh2, sc2, g2 = jnp.split(mod, 6, axis=-1)
        h = modulate(rms_norm(x, norm_g[layer, 0]), sh1, sc1)
        if layer < N_A_LAYERS:
            y = nsa_mixer(h, pos, a_w_in[layer], a_gate_b[layer], a_cmp_pe[layer], a_cmp_w1[layer], a_cmp_w2[layer], a_w_out[layer])
        else:
            if layer == N_A_LAYERS:
                kv_sh, kv_sc = jnp.split(c_act @ kv_mod_w + kv_mod_b, 2, axis=-1)
                hk = modulate(rms_norm(x, kv_norm_g), kv_sh, kv_sc)
                k_sh, v_sh = jnp.split(hk @ kv_w, 2, axis=-1)
                k_sh = k_sh.reshape(B, S, N_HEADS, HEAD_DIM)
                v_sh = v_sh.reshape(B, S, N_HEADS, HEAD_DIM)
            j = layer - N_A_LAYERS
            y = sb_mixer(h, k_sh, v_sh, b_w_q[j], b_w_out[j])
        x = x + g1[:, None, :] * rms_norm(y, norm_g[layer, 1])
        h = modulate(rms_norm(x, norm_g[layer, 2]), sh2, sc2)
        y = swiglu(h, ffn_w_in[layer], ffn_w_out[layer])
        x = x + g2[:, None, :] * rms_norm(y, norm_g[layer, 3])
    return x
```

```cpp
#include <hip/hip_runtime.h>
#include <cstdio>
#include <cstdint>
#include <type_traits>
namespace pg8 {
#define PG8_LAS __attribute__((address_space(3)))
typedef unsigned short bf16_t;
typedef short bf16x8 __attribute__((ext_vector_type(8)));
typedef float f32x4 __attribute__((ext_vector_type(4)));
typedef unsigned u32x4 __attribute__((ext_vector_type(4)));
constexpr int BM = 256, BK = 64, HALF = 128, HTB = HALF * BK * 2  , STAGE_BYTES = 8 * HTB, NXCD = 8, WGM = 8;

__host__ __device__ __forceinline__ int lds_byte(int r, int c) { const int st = (r >> 4) * 2 + (c >> 5), rr = r & 15, cc = c & 31, ob = rr * 64 + cc * 2; return st * 1024 + (ob ^ (((ob >> 9) & 1) << 5)); }
__host__ __device__ __forceinline__ void stage_rc(int b, int& R, int& C) { const int st = b / 1024, sb = b % 1024, swz = sb ^ (((sb >> 9) & 1) << 5); R = (st >> 1) * 16 + swz / 64; C = (st & 1) * 32 + (swz % 64) / 2; }
__host__ __device__ __forceinline__ int perm32(int rho) { const int n = rho >> 4, i = rho & 15; return 8 * (i >> 2) + 4 * n + (i & 3); }

struct Unit { int pm, pn; };
struct Gemm { const bf16_t* A; const bf16_t* Bt; int M, N, K; };

struct StaticOrder {
    int nM, nN, nwg, G, c;
    __host__ __device__ void init(int M, int N, int G_, int c_) { nM = M / BM; nN = N / BM; nwg = nM * nN; G = G_; c = c_; }
    __host__ __device__ bool next(int i, Unit& u) const {
        const long L = (long)i * G + c; if (L >= nwg) return false;
        int wgid = (int)L; { const int q = nwg / NXCD, r = nwg % NXCD, xcd = wgid % NXCD, off = wgid / NXCD; wgid = (xcd < r ? xcd * (q + 1) : r * (q + 1) + (xcd - r) * q) + off; }
        const int nig = WGM * nN, gid = wgid / nig, fm = gid * WGM, gsz = (nM - fm) < WGM ? (nM - fm) : WGM;
        u.pm = fm + ((wgid % nig) % gsz); u.pn = (wgid % nig) / gsz; return true;
    }
    __device__ __forceinline__ void a_ready(const Unit&) const {}
    __device__ __forceinline__ void done(const Unit&) const {}
};
typedef __bf16 bf16x2_t __attribute__((ext_vector_type(2)));
typedef float f32x2_t __attribute__((ext_vector_type(2)));
__device__ __forceinline__ unsigned cvt_pk_bf16(float lo, float hi) { f32x2_t v = {lo, hi}; bf16x2_t b = __builtin_convertvector(v, bf16x2_t); return __builtin_bit_cast(unsigned, b); }
typedef float f32x2 __attribute__((ext_vector_type(2)));
__device__ __forceinline__ f32x2 gelu_pk(f32x2 v) {
    const f32x2 av = __builtin_elementwise_abs(v), d = av * 0.2316418882f + 1.0f;
    f32x2 t; t.x = __builtin_amdgcn_rcpf(d.x); t.y = __builtin_amdgcn_rcpf(d.y);
    f32x2 q = t * 0.5307027145f + (-0.7265760135f); q = q * t + 0.7107068705f; q = q * t + (-0.142248368f); q = q * t + 0.127414796f; q = q * t;
    const f32x2 s = (v * v) * (-0.72134752044f);
    f32x2 e; e.x = __builtin_amdgcn_exp2f(s.x); e.y = __builtin_amdgcn_exp2f(s.y);
    const f32x2 m = v * (q * e), r = v - m;
    f32x2 o; o.x = v.x < 0.f ? m.x : r.x; o.y = v.y < 0.f ? m.y : r.y; return o;
}

template <int ACT  > struct EpiBf16 {
    static constexpr bool PERM = true, AFTER_DRAIN = false; static_assert(ACT == 0 || ACT == 1, "EpiBf16: ACT is 0 (none) or 1 (gelu_pk)");
    static constexpr int S_MIN = 16;
    bf16_t* O; int ldc; const float* bias; int split_cols; size_t split_stride; float scale0;
    __device__ __forceinline__ void operator()(const f32x4 (&acc)[2][2][4][2], const Unit& u, int wr, int wc, int fr, int fq) const {
        const int row0 = u.pm * BM + wr * 64 + fr; int colt = u.pn * BM; bf16_t* base = O;
        float sc = 1.f; if (split_cols) { const int t = colt / split_cols; base += (size_t)t * split_stride; colt -= t * split_cols; if (t == 0) sc = scale0; }
        const int col0 = colt + wc * 32 + 8 * fq, bcol0 = u.pn * BM + wc * 32 + 8 * fq;
        f32x4 bv[2][2];
#pragma unroll
        for (int bj = 0; bj < 2; ++bj)
#pragma unroll
            for (int n = 0; n < 2; ++n) bv[bj][n] = bias ? *(const f32x4*)(bias + bcol0 + bj * HALF + 4 * n) : (f32x4){0.f, 0.f, 0.f, 0.f};
#pragma unroll
        for (int ai = 0; ai < 2; ++ai)
#pragma unroll
            for (int m = 0; m < 4; ++m) { bf16_t* rowp = base + (size_t)(row0 + ai * HALF + m * 16) * ldc + col0;
#pragma unroll
                for (int bj = 0; bj < 2; ++bj) { f32x4 v0 = acc[ai][bj][m][0] + bv[bj][0], v1 = acc[ai][bj][m][1] + bv[bj][1];
                    if (ACT == 1) { f32x2 a = gelu_pk((f32x2){v0[0], v0[1]}), b = gelu_pk((f32x2){v0[2], v0[3]}), c = gelu_pk((f32x2){v1[0], v1[1]}), d = gelu_pk((f32x2){v1[2], v1[3]});
                        v0 = (f32x4){a.x, a.y, b.x, b.y}; v1 = (f32x4){c.x, c.y, d.x, d.y}; }
                    v0 = v0 * sc; v1 = v1 * sc; u32x4 w; w.x = cvt_pk_bf16(v0[0], v0[1]); w.y = cvt_pk_bf16(v0[2], v0[3]); w.z = cvt_pk_bf16(v1[0], v1[1]); w.w = cvt_pk_bf16(v1[2], v1[3]);
                    *(u32x4*)(rowp + bj * HALF) = w; } }
    }
};
struct EpiF32 {
    static constexpr bool PERM = false, AFTER_DRAIN = false;
    static constexpr int S_MIN = 16;
    float* C; int ldc;
    __device__ __forceinline__ void operator()(const f32x4 (&acc)[2][2][4][2], const Unit& u, int wr, int wc, int fr, int fq) const {
        const int row0 = u.pm * BM + wr * 64 + fr, col0 = u.pn * BM + wc * 32 + 4 * fq;
#pragma unroll
        for (int ai = 0; ai < 2; ++ai)
#pragma unroll
            for (int m = 0; m < 4; ++m) { float* rowp = C + (size_t)(row0 + ai * HALF + m * 16) * ldc + col0;
#pragma unroll
                for (int bj = 0; bj < 2; ++bj)
#pragma unroll
                    for (int n = 0; n < 2; ++n) *(f32x4*)(rowp + bj * HALF + n * 16) = acc[ai][bj][m][n]; }
    }
};
typedef unsigned u32x2 __attribute__((ext_vector_type(2)));
struct EpiNsaProj {
    static constexpr bool PERM = true, AFTER_DRAIN = false;
    static constexpr int S_MIN = 16;
    bf16_t* Q; bf16_t* KV6; const float* rope;
    __device__ __forceinline__ void operator()(const f32x4 (&acc)[2][2][4][2], const Unit& u, int wr, int wc, int fr, int fq) const {
        const int row0 = u.pm * BM + wr * 64 + fr, j = wc * 4 + fq;
        const int seg0 = u.pn * 2;
        bf16_t* dst; int ld; bool do_rope;
        if (seg0 < 16) { dst = Q + seg0 * 128; ld = 2048; do_rope = true; }
        else { const int s6 = (seg0 - 16) >> 2, gg = (seg0 - 16) & 3; dst = KV6 + (size_t)s6 * ((size_t)16384 * 512) + gg * 128; ld = 512; do_rope = (s6 == 0) || (s6 == 2) || (s6 == 4); }
#pragma unroll
        for (int ai = 0; ai < 2; ++ai)
#pragma unroll
            for (int mp = 0; mp < 2; ++mp) {
                f32x4 cs[2], sn[2];
                if (do_rope) {
#pragma unroll
                    for (int e = 0; e < 2; ++e) { const int row = row0 + ai * HALF + (2 * mp + e) * 16; const float* rp = rope + ((size_t)(row & 4095) * 64 + 4 * j) * 2;
                        const f32x4 c01 = *(const f32x4*)rp, c23 = *(const f32x4*)(rp + 4);
                        cs[e] = (f32x4){c01[0], c01[2], c23[0], c23[2]}; sn[e] = (f32x4){c01[1], c01[3], c23[1], c23[3]}; }
                }
#pragma unroll
                for (int bj = 0; bj < 2; ++bj) {
                    u32x2 w1[2], w2[2];
#pragma unroll
                    for (int e = 0; e < 2; ++e) { const int m = 2 * mp + e;
                        f32x4 x1 = acc[ai][bj][m][0], x2 = acc[ai][bj][m][1];
                        if (do_rope) { const f32x4 o1 = x1 * cs[e] - x2 * sn[e], o2 = x2 * cs[e] + x1 * sn[e]; x1 = o1; x2 = o2; }
                        w1[e].x = cvt_pk_bf16(x1[0], x1[1]); w1[e].y = cvt_pk_bf16(x1[2], x1[3]); w2[e].x = cvt_pk_bf16(x2[0], x2[1]); w2[e].y = cvt_pk_bf16(x2[2], x2[3]); }
                    const auto ax = __builtin_amdgcn_permlane16_swap(w1[0].x, w1[1].x, false, false), ay = __builtin_amdgcn_permlane16_swap(w1[0].y, w1[1].y, false, false);
                    const auto bx = __builtin_amdgcn_permlane16_swap(w2[0].x, w2[1].x, false, false), by = __builtin_amdgcn_permlane16_swap(w2[0].y, w2[1].y, false, false);
                    u32x4 o1, o2; o1.x = ax[0]; o1.y = ay[0]; o1.z = ax[1]; o1.w = ay[1]; o2.x = bx[0]; o2.y = by[0]; o2.z = bx[1]; o2.w = by[1];
                    bf16_t* rp2 = dst + bj * 128 + (size_t)(row0 + ai * HALF + (2 * mp + (fq & 1)) * 16) * ld + 4 * (j & ~1);
                    *(u32x4*)rp2 = o1; *(u32x4*)(rp2 + 64) = o2; }
            }
    }
};
struct EpiSwiglu {
    static constexpr bool PERM = true, AFTER_DRAIN = false;
    static constexpr int S_MIN = 8;
    bf16_t* O; int ldc;
    __device__ __forceinline__ u32x2 act4(const f32x4& g, const f32x4& up) const { f32x4 r;
#pragma unroll
        for (int i = 0; i < 4; ++i) r[i] = g[i] * __builtin_amdgcn_rcpf(1.0f + __builtin_amdgcn_exp2f(g[i])) * up[i];
        u32x2 w; w.x = cvt_pk_bf16(r[0], r[1]); w.y = cvt_pk_bf16(r[2], r[3]); return w; }
    __device__ __forceinline__ void operator()(const f32x4 (&acc)[2][2][4][2], const Unit& u, int wr, int wc, int fr, int fq) const {
        const int row0 = u.pm * BM + wr * 64 + fr + (fq & 1) * 16, col0 = (u.pn * BM + wc * 32 + 8 * (fq & ~1)) >> 1;
#pragma unroll
        for (int ai = 0; ai < 2; ++ai)
#pragma unroll
            for (int mp = 0; mp < 2; ++mp) { bf16_t* rowp = O + (size_t)(row0 + ai * HALF + mp * 32) * ldc + col0;
#pragma unroll
                for (int bj = 0; bj < 2; ++bj) { const u32x2 wa = act4(acc[ai][bj][2 * mp][0], acc[ai][bj][2 * mp][1]), wb = act4(acc[ai][bj][2 * mp + 1][0], acc[ai][bj][2 * mp + 1][1]);
                    const auto sx = __builtin_amdgcn_permlane16_swap(wa.x, wb.x, false, false), sy = __builtin_amdgcn_permlane16_swap(wa.y, wb.y, false, false);
                    u32x4 w; w.x = sx[0]; w.y = sy[0]; w.z = sx[1]; w.w = sy[1];
                    *(u32x4*)(rowp + bj * (HALF / 2)) = w; } }
    }
};
template <class Epi, class Sched, bool ALIGN_EPI = false, bool SP2 = false>
__device__ __forceinline__ void gemm_phase(PG8_LAS unsigned char* lds, const Gemm g, const Sched& S, const Epi& E, int tid_in) {
    int tid_ = tid_in; asm volatile("" : "+v"(tid_));
    const int tid = tid_, wid = __builtin_amdgcn_readfirstlane(tid >> 6), lane = tid & 63, wr = wid >> 2, wc = wid & 3, fr = lane & 15, fq = lane >> 4;
    const int K = g.K, nt = K / BK;
    unsigned voffA[2], voffB[2];
#pragma unroll
    for (int i = 0; i < 2; ++i) { int R, C; stage_rc(tid * 16 + i * 8192, R, C); const int Rb = Epi::PERM ? ((R & ~31) + perm32(R & 31)) : R;
        voffA[i] = (unsigned)(R * K + C) * 2u; voffB[i] = (unsigned)(Rb * K + C) * 2u; }
    const size_t kstep = (size_t)(BK * 2);
    const size_t hstep = (size_t)HALF * K * 2;
    const size_t tstep = 2 * hstep;
    const unsigned ldsw = (unsigned)wid * 1024u;
    const int aoff = lds_byte(wr * 64 + fr, fq * 8), boff = lds_byte(wc * 32 + fr, fq * 8);
#define PG8_SA(b, h) (((b) * 2 + (h)) * HTB)
#define PG8_SB(b, h) ((4 + (b) * 2 + (h)) * HTB)
#define PG8_STAGE(bufoff, gbase, voff) do { _Pragma("unroll") for (int _i = 0; _i < 2; ++_i) \
        __builtin_amdgcn_global_load_lds((const unsigned*)((const char*)(gbase) + (voff)[_i]), (PG8_LAS unsigned*)(lds + (bufoff) + ldsw + _i * 8192), 16, 0, 0); } while (0)
#define PG8_LDA(dst, b, h) do { _Pragma("unroll") for (int m = 0; m < 4; ++m) _Pragma("unroll") for (int k = 0; k < 2; ++k) dst[m][k] = *(const PG8_LAS bf16x8*)(lds + PG8_SA(b, h) + aoff + m * 2048 + k * 1024); } while (0)
#define PG8_LDB(dst, b, h) do { _Pragma("unroll") for (int n = 0; n < 2; ++n) _Pragma("unroll") for (int k = 0; k < 2; ++k) dst[n][k] = *(const PG8_LAS bf16x8*)(lds + PG8_SB(b, h) + boff + n * 2048 + k * 1024); } while (0)
#define PG8_MMA(ai, bj, At, Bt) do { __builtin_amdgcn_s_setprio(1); _Pragma("unroll") for (int m = 0; m < 4; ++m) _Pragma("unroll") for (int n = 0; n < 2; ++n) _Pragma("unroll") for (int k = 0; k < 2; ++k) \
        acc[ai][bj][m][n] = __builtin_amdgcn_mfma_f32_16x16x32_bf16(Bt[n][k], At[m][k], acc[ai][bj][m][n], 0, 0, 0); __builtin_amdgcn_s_setprio(0); } while (0)
#define PG8_WAIT_V(n) asm volatile("s_waitcnt vmcnt(" #n ")" ::: "memory")
#define PG8_WAIT_L(n) asm volatile("s_waitcnt lgkmcnt(" #n ")" ::: "memory")
#define PG8_BAR __builtin_amdgcn_s_barrier()
#define PG8_SCHED __builtin_amdgcn_sched_barrier(0)
    static_assert(ALIGN_EPI && SP2, "this copy keeps only the two-super-phase loop with aligned epilogues");
    Unit cur, nxt; int ui = 0;
    if (!S.next(0, cur)) return;
    f32x4 acc[2][2][4][2];
#pragma unroll
    for (int a = 0; a < 2; ++a)
#pragma unroll
        for (int b = 0; b < 2; ++b)
#pragma unroll
            for (int m = 0; m < 4; ++m)
#pragma unroll
                for (int n = 0; n < 2; ++n) { acc[a][b][m][n] = (f32x4){0.f, 0.f, 0.f, 0.f}; asm volatile("" : "+v"(acc[a][b][m][n])); }
    bf16x8 At[4][2], B0[2][2], B1[2][2];
    const char* cA = (const char*)g.A + (size_t)cur.pm * tstep; const char* cB = (const char*)g.Bt + (size_t)cur.pn * tstep;
    const char* nA = cA; const char* nB = cB; bool has_next = false;
    S.a_ready(cur);
    PG8_STAGE(PG8_SB(0, 0), cB, voffB); PG8_STAGE(PG8_SB(0, 1), cB + hstep, voffB); PG8_STAGE(PG8_SA(0, 0), cA, voffA); PG8_STAGE(PG8_SA(0, 1), cA + hstep, voffA);
    PG8_STAGE(PG8_SB(1, 0), cB + kstep, voffB); PG8_STAGE(PG8_SA(1, 0), cA + kstep, voffA); PG8_STAGE(PG8_SB(1, 1), cB + hstep + kstep, voffB); PG8_STAGE(PG8_SA(1, 1), cA + hstep + kstep, voffA);
    if (wr == 1) PG8_BAR;
    PG8_WAIT_V(0); PG8_BAR; PG8_BAR;
    constexpr int W0 = 10 + Epi::S_MIN;
    auto ktiles = [&](const int t, const int nt_, const int first) __attribute__((always_inline)) {
        const bool last = (t == nt_ - 2);
        const char* a1 = cA + (size_t)(t + 1) * kstep;
        const char* a2 = last ? nA : cA + (size_t)(t + 2) * kstep; const char* b2 = last ? nB : cB + (size_t)(t + 2) * kstep;
        const char* a3 = a2 + kstep; const char* b3 = b2 + kstep;
        if (last && has_next) S.a_ready(nxt);
        PG8_LDB(B0, 0, 0); PG8_LDB(B1, 0, 1); PG8_SCHED; PG8_LDA(At, 0, 0); PG8_STAGE(PG8_SA(1, 1), a1 + hstep, voffA);
        if (first) asm volatile("s_waitcnt vmcnt(%0)" :: "n"(W0) : "memory"); else PG8_WAIT_V(8); PG8_WAIT_L(0); PG8_BAR; PG8_MMA(0, 0, At, B0); PG8_MMA(0, 1, At, B1); PG8_BAR; PG8_SCHED;
        PG8_LDA(At, 0, 1); PG8_STAGE(PG8_SB(0, 0), b2, voffB); PG8_STAGE(PG8_SB(0, 1), b2 + hstep, voffB); PG8_STAGE(PG8_SA(0, 0), a2, voffA);
        if (first) asm volatile("s_waitcnt vmcnt(%0)" :: "n"(W0) : "memory"); else PG8_WAIT_V(8); PG8_WAIT_L(0); PG8_BAR; PG8_MMA(1, 0, At, B0); PG8_MMA(1, 1, At, B1); PG8_BAR; PG8_SCHED;
        PG8_LDB(B0, 1, 0); PG8_LDB(B1, 1, 1); PG8_SCHED; PG8_LDA(At, 1, 0); PG8_STAGE(PG8_SA(0, 1), a2 + hstep, voffA);
        if (first) asm volatile("s_waitcnt vmcnt(%0)" :: "n"(W0) : "memory"); else PG8_WAIT_V(8); PG8_WAIT_L(0); PG8_BAR; PG8_MMA(0, 0, At, B0); PG8_MMA(0, 1, At, B1); PG8_BAR; PG8_SCHED;
        PG8_LDA(At, 1, 1); PG8_STAGE(PG8_SB(1, 0), b3, voffB); PG8_STAGE(PG8_SB(1, 1), b3 + hstep, voffB); PG8_STAGE(PG8_SA(1, 0), a3, voffA);
        PG8_WAIT_V(8); PG8_WAIT_L(0); PG8_BAR; PG8_MMA(1, 0, At, B0); PG8_MMA(1, 1, At, B1); PG8_BAR; PG8_SCHED;
    };
    for (;;) {
        has_next = S.next(ui + 1, nxt);
        nA = has_next ? (const char*)g.A + (size_t)nxt.pm * tstep : cA; nB = has_next ? (const char*)g.Bt + (size_t)nxt.pn * tstep : cB;
        int sm = 1; asm volatile("" : "+s"(sm));
#pragma nounroll
        for (int t = 0; t < nt; t += 2) { ktiles(t, nt, sm); sm = 0; asm volatile("" : "+s"(sm)); }
        if (wr == 0) PG8_BAR;
        if (has_next) PG8_STAGE(PG8_SA(1, 1), nA + kstep + hstep, voffA);
        if constexpr (!Epi::AFTER_DRAIN) { E(acc, cur, wr, wc, fr, fq); S.done(cur); }
        if (!has_next) break;
#pragma unroll
        for (int a = 0; a < 2; ++a)
#pragma unroll
            for (int b = 0; b < 2; ++b)
#pragma unroll
                for (int m = 0; m < 4; ++m)
#pragma unroll
                    for (int n = 0; n < 2; ++n) { acc[a][b][m][n] = (f32x4){0.f, 0.f, 0.f, 0.f}; asm volatile("" : "+v"(acc[a][b][m][n])); }
        cur = nxt; cA = nA; cB = nB; ++ui;
        if (wr == 1) PG8_BAR;
    }
    PG8_WAIT_V(0);
    PG8_BAR;
    if constexpr (Epi::AFTER_DRAIN) { E.fused(acc, cur, wr, wc, fr, fq, lds, wid, lane); S.done(cur); }
#undef PG8_SA
#undef PG8_SB
#undef PG8_STAGE
#undef PG8_LDA
#undef PG8_LDB
#undef PG8_MMA
#undef PG8_WAIT_V
#undef PG8_WAIT_L
#undef PG8_BAR
#undef PG8_SCHED
}
}

constexpr int NB_ = 4, S_ = 4096, D_ = 2048, M_ = NB_ * S_, NH = 16, HD = 128, NG = 4, DFF = 5632, NIN = 5168, NINP = 5376, NPROJ = 5120  , NLAYER = 4;
constexpr int NCP = 256;
constexpr float EPS = 1e-6f;
constexpr float SCALE = 0.08838834764831845f;
constexpr float C2 = SCALE * 1.4426950408889634f;
constexpr int NWAVES = 8, NTHR = 512;

constexpr size_t MiB = 1u << 20;
constexpr size_t WS_CTL = 0, CTL_ZERO_BYTES = 1 * MiB;
constexpr size_t WS_MODV = 1 * MiB;
constexpr size_t WS_KVMOD = WS_MODV + (size_t)4 * 4 * 12288 * 4;
constexpr size_t WS_PEB = WS_KVMOD + (size_t)4 * 4096 * 4;
constexpr size_t WS_ROPE = 2 * MiB;
constexpr size_t WS_WAIN = 4 * MiB;
constexpr size_t SZ_WAIN = (size_t)NINP * D_ * 2;
constexpr size_t WS_WAOUT = WS_WAIN + 2 * SZ_WAIN;
constexpr size_t SZ_WSQ = (size_t)D_ * D_ * 2;
constexpr size_t WS_WBQ = WS_WAOUT + 2 * SZ_WSQ;
constexpr size_t WS_WBOUT = WS_WBQ + 2 * SZ_WSQ;
constexpr size_t WS_WKV = WS_WBOUT + 2 * SZ_WSQ;
constexpr size_t WS_WFIN = WS_WKV + 2 * SZ_WSQ;
constexpr size_t SZ_WFIN = (size_t)2 * DFF * D_ * 2;
constexpr size_t WS_WFOUT = WS_WFIN + 4 * SZ_WFIN;
constexpr size_t SZ_WFOUT = (size_t)D_ * DFF * 2;
constexpr size_t WS_WC1 = WS_WFOUT + 4 * SZ_WFOUT;
constexpr size_t SZ_WC1 = (size_t)256 * 4096 * 2;
constexpr size_t WS_WC2 = WS_WC1 + 4 * SZ_WC1;
constexpr size_t SZ_WC2 = (size_t)128 * 256 * 2;
constexpr size_t WS_WG = WS_WC2 + 4 * SZ_WC2;
constexpr size_t SZ_WG = (size_t)64 * D_ * 2;
constexpr size_t WS_ACT0 = (WS_WG + 2 * SZ_WG + MiB - 1) / MiB * MiB;
constexpr size_t SZ_MD2 = (size_t)M_ * D_ * 2;
constexpr size_t WS_H = WS_ACT0;
constexpr size_t WS_HK = WS_H + SZ_MD2;
constexpr size_t WS_Q = WS_HK + SZ_MD2;
constexpr size_t WS_KV6 = WS_Q + SZ_MD2;
constexpr size_t WS_GATES = WS_KV6 + (size_t)6 * M_ * 512 * 2;
constexpr size_t WS_KCMP = WS_GATES + (size_t)M_ * 48 * 4;
constexpr size_t WS_O = WS_KCMP + (size_t)2 * 16 * NCP * HD * 2;
constexpr size_t WS_Y = WS_O + SZ_MD2;
constexpr size_t WS_ACT = WS_Y + 2 * SZ_MD2;
constexpr size_t WS_KSH = WS_ACT + (size_t)M_ * DFF * 2;
constexpr size_t WS_VSH = WS_KSH + SZ_MD2;
constexpr size_t WS_STASH = WS_VSH + SZ_MD2;
constexpr size_t WS_XB = WS_STASH + (size_t)256 * 32768 * 4;
constexpr size_t WS_END = WS_XB + SZ_MD2;
constexpr int CW_BAR = 4096;
constexpr int CW_DBG = 16384;

constexpr int RING_BYTES = 131072;
constexpr int LDS_BYTES = 147456;
constexpr int LDSCTL_OFF = LDS_BYTES - 1024, MISC_OFF = LDSCTL_OFF + 320;

#define GAS __attribute__((address_space(1)))
#define LAS __attribute__((address_space(3)))
typedef unsigned short bf16;
typedef unsigned u32x4 __attribute__((ext_vector_type(4)));
typedef unsigned u32x2 __attribute__((ext_vector_type(2)));
typedef float f32x4 __attribute__((ext_vector_type(4)));
typedef float f32x2 __attribute__((ext_vector_type(2)));
typedef float f32x16 __attribute__((ext_vector_type(16)));
typedef short bf16x8 __attribute__((ext_vector_type(8)));
typedef short s16x4 __attribute__((ext_vector_type(4)));
#define LDS_WAIT() asm volatile("s_waitcnt lgkmcnt(0)" ::: "memory")
#define VM_WAIT() asm volatile("s_waitcnt vmcnt(0)" ::: "memory")
#define SBAR() __builtin_amdgcn_sched_barrier(0)
__device__ __forceinline__ unsigned cvtpk(float lo, float hi) { return pg8::cvt_pk_bf16(lo, hi); }
__device__ __forceinline__ float bf2f(bf16 v) { return __uint_as_float(((unsigned)v) << 16); }
__device__ __forceinline__ float lx1(float v) { return __int_as_float(__builtin_amdgcn_mov_dpp(__float_as_int(v), 0xB1, 0xF, 0xF, true)); }
__device__ __forceinline__ float lx2(float v) { return __int_as_float(__builtin_amdgcn_mov_dpp(__float_as_int(v), 0x4E, 0xF, 0xF, true)); }
template <int X> __device__ __forceinline__ float lswz(float v) { return __int_as_float(__builtin_amdgcn_ds_swizzle(__float_as_int(v), 0x1F | (X << 10))); }
__device__ __forceinline__ float wave_sum(float v) {
    v += lx1(v); v += lx2(v); v += lswz<4>(v); v += lswz<8>(v); v += lswz<16>(v);
    auto rr = __builtin_amdgcn_permlane32_swap(__float_as_uint(v), __float_as_uint(v), false, false);
    return __uint_as_float(rr[0]) + __uint_as_float(rr[1]);
}

#define XB_TMO      128
#define XB_XCNT(j)  (256  + 64 * (j))
#define XB_XSUB(j)  (1280 + 64 * (j))
#define XB_XGEN(j)  (2304 + 64 * (j))
#define XB_TOP      3328
#define XB_TOPGEN   3392
#define XB_GCNT(j)  (3456 + 64 * (j))
#define XB_XID      4096
#define XCD_BAR_WORDS 3456
#define XB_SPIN_CAP (1u << 18)
__device__ __forceinline__ unsigned xb_ld(unsigned* p)              { return __hip_atomic_load(p, __ATOMIC_RELAXED, __HIP_MEMORY_SCOPE_AGENT); }
__device__ __forceinline__ unsigned xb_add(unsigned* p, unsigned v) { return __hip_atomic_fetch_add(p, v, __ATOMIC_RELAXED, __HIP_MEMORY_SCOPE_AGENT); }
__device__ __forceinline__ unsigned xb_xcc_id() { return (unsigned)__builtin_amdgcn_s_getreg((3 << 11) | 20) & 0xFu; }
#define XB_SPIN(cond, bar) do { unsigned _sp = 0; while (cond) { __builtin_amdgcn_s_sleep(1); \
    if ((++_sp & 255u) == 0u) { if (xb_ld(&(bar)[XB_TMO])) break; if (_sp > XB_SPIN_CAP) { atomicAdd(&(bar)[XB_TMO], 1u); break; } } } } while (0)
struct XcdBarrier { unsigned* bar; unsigned x; volatile LAS unsigned* st; };
__device__ __forceinline__ XcdBarrier xcd_barrier_post(unsigned* bar, volatile LAS unsigned* st, bool leader  ) {
    XcdBarrier b; b.bar = bar; b.x = xb_xcc_id(); b.st = st;
    if (leader) { (void)xb_add(&bar[XB_XCNT(b.x)], 1u); __hip_atomic_store(&bar[XB_XID + blockIdx.x], b.x + 1u, __ATOMIC_RELAXED, __HIP_MEMORY_SCOPE_AGENT); }
    return b;
}
__device__ __forceinline__ void xcd_barrier_complete(unsigned* bar, unsigned x, unsigned& nloc, unsigned& nx) {
    const unsigned G = gridDim.x * gridDim.y * gridDim.z;
    unsigned sum, cnt, mine, sp = 0u;
    for (;;) {
        sum = 0u; cnt = 0u; mine = 0u;
#pragma unroll
        for (unsigned j = 0; j < 16; ++j) { const unsigned c = xb_ld(&bar[XB_XCNT(j)]); sum += c; cnt += (c > 0u) ? 1u : 0u; mine = (j == x) ? c : mine; }
        if (sum == G) break;
        __builtin_amdgcn_s_sleep(1);
        if ((++sp & 255u) == 0u) { if (xb_ld(&bar[XB_TMO])) break; if (sp > XB_SPIN_CAP) { atomicAdd(&bar[XB_TMO], 1u); break; } }
    }
    nloc = mine > 0u ? mine : 1u; nx = cnt > 0u ? cnt : 1u;
}
__device__ __forceinline__ void xcd_barrier(const XcdBarrier& b, bool leader  ) {
    asm volatile("s_waitcnt vmcnt(0)" ::: "memory");
    __syncthreads();
    if (leader) {
        unsigned* bar = b.bar;
        __builtin_amdgcn_s_waitcnt(0);
        unsigned nloc = b.st[0], nx = b.st[1];
        if (nloc == 0u) { xcd_barrier_complete(bar, b.x, nloc, nx); b.st[0] = nloc; b.st[1] = nx; }
        const unsigned old = xb_add(&bar[XB_XSUB(b.x)], 1u);
        const unsigned gen = old / nloc;
        if (old + 1u == (gen + 1u) * nloc) {
            __builtin_amdgcn_fence(__ATOMIC_RELEASE, "agent");
            asm volatile("s_waitcnt vmcnt(0)" ::: "memory");
            const unsigned og = xb_add(&bar[XB_TOP], 1u);
            const unsigned tg = og / nx;
            if (og + 1u == (tg + 1u) * nx) xb_add(&bar[XB_TOPGEN], 1u);
            else XB_SPIN(xb_ld(&bar[XB_TOPGEN]) == tg, bar);
            __builtin_amdgcn_fence(__ATOMIC_ACQUIRE, "agent");
            xb_add(&bar[XB_XGEN(b.x)], 1u);
            asm volatile("s_waitcnt vmcnt(0)" ::: "memory");
        } else {
            XB_SPIN(xb_ld(&bar[XB_XGEN(b.x)]) == gen, bar);
            __builtin_amdgcn_fence(__ATOMIC_ACQUIRE, "agent");
            asm volatile("s_waitcnt vmcnt(0)" ::: "memory");
        }
    }
    __syncthreads();
}

__device__ __forceinline__ void group_barrier(const XcdBarrier& b, int tid) {
    const bool leader = (tid == 0);
    if (b.st[2] == 0u) {
        if (tid < (int)gridDim.x) { const unsigned a = xb_ld(&b.bar[XB_XID + tid]), f = xb_ld(&b.bar[XB_XID + (tid & 7)]); if (a == 0u || a != f) b.st[3] = 1u; }
        if (tid < 8) { const unsigned a = xb_ld(&b.bar[XB_XID + tid]); for (int u = 0; u < tid; ++u) if (xb_ld(&b.bar[XB_XID + u]) == a) b.st[3] = 1u; }
        __syncthreads();
        if (leader) b.st[2] = (gridDim.x == 256u && b.st[3] == 0u) ? 1u : 2u;
        __syncthreads();
    }
    if (b.st[2] != 1u) { xcd_barrier(b, leader); return; }
    asm volatile("s_waitcnt vmcnt(0)" ::: "memory");
    __syncthreads();
    if (leader) {
        unsigned* bar = b.bar; const unsigned g = blockIdx.x & 7u;
        const unsigned old = xb_add(&bar[XB_GCNT(g)], 1u);
        const unsigned target = (old / 32u + 1u) * 32u;
        XB_SPIN(xb_ld(&bar[XB_GCNT(g)]) < target, bar);
        __builtin_amdgcn_fence(__ATOMIC_ACQUIRE, "agent");
        asm volatile("s_waitcnt vmcnt(0)" ::: "memory");
    }
    __syncthreads();
}

__device__ __forceinline__ int mk_tid(int wave_s) { int l; asm volatile("v_mbcnt_lo_u32_b32 %0, -1, 0\n\tv_mbcnt_hi_u32_b32 %0, -1, %0" : "=v"(l)); return (wave_s << 6) | l; }
struct Args { const float* in[19]; float* out; unsigned char* ws; int ph_lo, ph_hi, dbg, pad; float inv[64]; };
enum { I_X = 0, I_C, I_MODW, I_MODB, I_NORMG, I_FWIN, I_FWOUT, I_AWIN, I_AGATEB, I_APE, I_AW1, I_AW2, I_AWOUT, I_BWQ, I_BWOUT, I_KVNG, I_KVMODW, I_KVMODB, I_KVW };
struct Frame {
    LAS unsigned char* lds;
    int tid, lane, wave, vcu, G;
    unsigned char* ws;
};

template <int MODE> __device__ __forceinline__ int src_col(int c) {
    if (MODE == 0) return c;
    if (MODE == 1) { const int g8 = c >> 3, i = c & 7; return (i < 4) ? g8 * 4 + i : DFF + g8 * 4 + (i - 4); }
    if (MODE == 3) return (c < 48) ? 5120 + c : -1;
    if (c >= NIN) return -1;
    if (c >= 5120) return c;
    const int hb = c & ~127, p = c & 127, jj = p >> 3, i = p & 7;
    return hb + ((i < 4) ? 4 * jj + i : 64 + 4 * jj + (i - 4));
}
template <int MODE, int DST = 0> __device__ __forceinline__ void p0_transpose_item(const float* W, int K, int ld, bf16* WT, LAS float* scr, int item, int nblk, int lane) {
    const int kb = item / nblk, nb = item - kb * nblk, k0 = 64 * kb, n0 = 64 * nb;
    const int c4 = (lane & 15) * 4, sc = src_col<MODE>(n0 + c4), kr = lane >> 4;
    f32x4 v[16];
#pragma unroll
    for (int i = 0; i < 16; ++i) v[i] = (sc >= 0) ? *(const f32x4*)(W + (size_t)(k0 + kr + 4 * i) * ld + sc) : (f32x4){0.f, 0.f, 0.f, 0.f};
    if (MODE == 1) {
        const float f_ = ((n0 + c4) & 4) ? -0.6931471805599453f : -1.4426950408889634f;
#pragma unroll
        for (int i = 0; i < 16; ++i) v[i] *= f_; }
#pragma unroll
    for (int i = 0; i < 16; ++i) { LAS float* s = scr + (kr + 4 * i) * 65 + c4; s[0] = v[i][0]; s[1] = v[i][1]; s[2] = v[i][2]; s[3] = v[i][3]; }
    LDS_WAIT(); asm volatile("" ::: "memory");
#pragma unroll
    for (int t = 0; t < 8; ++t) { const int q = lane + 64 * t, n = q >> 3, c = q & 7; const LAS float* s = scr + (8 * c) * 65 + n;
        u32x4 o; o.x = cvtpk(s[0], s[65]); o.y = cvtpk(s[2 * 65], s[3 * 65]); o.z = cvtpk(s[4 * 65], s[5 * 65]); o.w = cvtpk(s[6 * 65], s[7 * 65]);
        if (DST == 0) *(u32x4*)(WT + (size_t)(n0 + n) * K + k0 + 8 * c) = o;
        else if (DST == 2) { const int nn = n0 + n, kk = k0 + 8 * c;
            *(u32x4*)(WT + ((size_t)(((nn >> 5) * (K >> 6) + (kk >> 6)) * 4 + ((kk >> 3) & 3)) * 64 + ((kk >> 5) & 1) * 32 + (nn & 31)) * 8) = o; }
        else { const int nn = n0 + n, kk = k0 + 8 * c;
            *(u32x4*)(WT + ((size_t)((nn >> 5) * (K >> 4) + (kk >> 4)) * 64 + ((kk >> 3) & 1) * 32 + (nn & 31)) * 8) = o; } }
    LDS_WAIT(); asm volatile("" ::: "memory");
}
template <int NB, int K> __device__ __forceinline__ void gemv_item(const float* W, int ldw, int col0, const LAS float* xs, LAS float* red, const float* bias, float* out, int ostride, Frame& F) {
    constexpr int kper = K / 8; const int kbeg = F.wave * kper;
    f32x4 acc[NB];
#pragma unroll
    for (int b = 0; b < NB; ++b) acc[b] = (f32x4){0.f, 0.f, 0.f, 0.f};
    const float* wp = W + (size_t)kbeg * ldw + col0 + 4 * F.lane;
    for (int k = 0; k < kper; k += 8) {
        f32x4 w[8];
#pragma unroll
        for (int u = 0; u < 8; ++u) w[u] = *(const f32x4*)(wp + (size_t)(k + u) * ldw);
#pragma unroll
        for (int u = 0; u < 8; ++u)
#pragma unroll
            for (int b = 0; b < NB; ++b) { const float x = xs[b * K + kbeg + k + u]; acc[b] += w[u] * x; }
    }
#pragma unroll
    for (int b = 0; b < NB; ++b) *(LAS f32x4*)(red + ((F.wave * NB + b) * 256 + 4 * F.lane)) = acc[b];
    __syncthreads();
    for (int e = F.tid; e < NB * 256; e += NTHR) { const int b = e >> 8, c = e & 255; float s = 0.f;
#pragma unroll
        for (int w = 0; w < 8; ++w) s += red[(w * NB + b) * 256 + c];
        out[(size_t)b * ostride + col0 + c] = s + (bias ? bias[col0 + c] : 0.f); }
    __syncthreads();
}
__device__ __forceinline__ void sincos_acc(float ang, float& c, float& s) {
    const double x = (double)ang;
    const double k = rint(x * 0.63661977236758134308);
    double r = fma(-k, 1.57079632679489655800, x); r = fma(-k, 6.123233995736766e-17, r);
    const int q = ((int)k) & 3;
    const double r2 = r * r;
    const double sp = r * (1.0 + r2 * (-1.0 / 6 + r2 * (1.0 / 120 + r2 * (-1.0 / 5040 + r2 * (1.0 / 362880 + r2 * (-1.0 / 39916800 + r2 * (1.0 / 6227020800.0)))))));
    const double cp = 1.0 + r2 * (-0.5 + r2 * (1.0 / 24 + r2 * (-1.0 / 720 + r2 * (1.0 / 40320 + r2 * (-1.0 / 3628800 + r2 * (1.0 / 479001600.0 + r2 * (-1.0 / 87178291200.0)))))));
    const double sv = (q == 0) ? sp : (q == 1) ? cp : (q == 2) ? -sp : -cp;
    const double cv = (q == 0) ? cp : (q == 1) ? -sp : (q == 2) ? -cp : sp;
    c = (float)cv; s = (float)sv;
}
__device__ __forceinline__ void p0_prologue(Frame& F, const Args& a) {
    unsigned char* ws = F.ws;
    { float* rope = (float*)(ws + WS_ROPE);
      for (int i = blockIdx.x * NTHR + F.tid; i < S_ * 64; i += F.G * NTHR) { const int s = i >> 6, j = i & 63; float c, sn; sincos_acc((float)s * a.inv[j], c, sn); rope[2 * i] = c; rope[2 * i + 1] = sn; } }
    { LAS float* xs = (LAS float*)F.lds; LAS float* red = (LAS float*)(F.lds + 32768);
      for (int it = blockIdx.x; it < 212; it += F.G) {
          if (it < 208) {
              for (int e = F.tid; e < NB_ * D_; e += NTHR) { const float c = a.in[I_C][e]; xs[e] = c / (1.0f + __expf(-c)); }
              __syncthreads();
              if (it < 192) { const int l = it / 48, ch = it - l * 48;
                  gemv_item<4, D_>(a.in[I_MODW] + (size_t)l * D_ * 12288, 12288, ch * 256, xs, red, a.in[I_MODB] + l * 12288, (float*)(ws + WS_MODV) + (size_t)l * 4 * 12288, 12288, F); }
              else { const int ch = it - 192;
                  gemv_item<4, D_>(a.in[I_KVMODW], 4096, ch * 256, xs, red, a.in[I_KVMODB], (float*)(ws + WS_KVMOD), 4096, F); }
          } else { const int lt = it - 208;
              for (int e = F.tid; e < 4096; e += NTHR) xs[e] = a.in[I_APE][(size_t)lt * 4096 + e];
              __syncthreads();
              gemv_item<1, 4096>(a.in[I_AW1] + (size_t)lt * 4096 * 256, 256, 0, xs, red, nullptr, (float*)(ws + WS_PEB) + lt * 256, 256, F); }
      } }
    __syncthreads();
    { LAS float* scr = (LAS float*)(F.lds + F.wave * 16640);
      const int gw = blockIdx.x * NWAVES + F.wave, NGW = F.G * NWAVES;
      constexpr int C_AIN = 32 * (NPROJ / 64), C_SQ = 32 * 32, C_KV = 32 * 64, C_FIN = 32 * (2 * DFF / 64), C_FOUT = (DFF / 64) * 32, C_W1 = 64 * 4, C_W2 = 4 * 2, C_WG = 32;
      constexpr int NITEMS = 2 * C_AIN + 6 * C_SQ + C_KV + 4 * C_FIN + 4 * C_FOUT + 4 * C_W1 + 4 * C_W2 + 2 * C_WG;
      for (int it = gw; it < NITEMS; it += NGW) {
          int r = it;
          if (r < 4 * C_FIN) { const int l = r / C_FIN; r -= l * C_FIN; p0_transpose_item<1>(a.in[I_FWIN] + (size_t)l * D_ * 2 * DFF, D_, 2 * DFF, (bf16*)(ws + WS_WFIN + l * SZ_WFIN), scr, r, 2 * DFF / 64, F.lane); continue; } r -= 4 * C_FIN;
          if (r < 4 * C_FOUT) { const int l = r / C_FOUT; r -= l * C_FOUT; p0_transpose_item<0>(a.in[I_FWOUT] + (size_t)l * DFF * D_, DFF, D_, (bf16*)(ws + WS_WFOUT + l * SZ_WFOUT), scr, r, D_ / 64, F.lane); continue; } r -= 4 * C_FOUT;
          if (r < 2 * C_AIN) { const int l = r / C_AIN; r -= l * C_AIN; p0_transpose_item<2>(a.in[I_AWIN] + (size_t)l * D_ * NIN, D_, NIN, (bf16*)(ws + WS_WAIN + l * SZ_WAIN), scr, r, NPROJ / 64, F.lane); continue; } r -= 2 * C_AIN;
          if (r < 2 * C_SQ) { const int l = r / C_SQ; r -= l * C_SQ; p0_transpose_item<0>(a.in[I_AWOUT] + (size_t)l * D_ * D_, D_, D_, (bf16*)(ws + WS_WAOUT + l * SZ_WSQ), scr, r, D_ / 64, F.lane); continue; } r -= 2 * C_SQ;
          if (r < 2 * C_SQ) { const int l = r / C_SQ; r -= l * C_SQ; p0_transpose_item<0>(a.in[I_BWQ] + (size_t)l * D_ * D_, D_, D_, (bf16*)(ws + WS_WBQ + l * SZ_WSQ), scr, r, D_ / 64, F.lane); continue; } r -= 2 * C_SQ;
          if (r < 2 * C_SQ) { const int l = r / C_SQ; r -= l * C_SQ; p0_transpose_item<0>(a.in[I_BWOUT] + (size_t)l * D_ * D_, D_, D_, (bf16*)(ws + WS_WBOUT + l * SZ_WSQ), scr, r, D_ / 64, F.lane); continue; } r -= 2 * C_SQ;
          if (r < C_KV) { p0_transpose_item<0>(a.in[I_KVW], D_, 2 * D_, (bf16*)(ws + WS_WKV), scr, r, 2 * D_ / 64, F.lane); continue; } r -= C_KV;
          if (r < 4 * C_W1) { const int l = r / C_W1; r -= l * C_W1; p0_transpose_item<0, 1>(a.in[I_AW1] + (size_t)l * 4096 * 256, 4096, 256, (bf16*)(ws + WS_WC1 + l * SZ_WC1), scr, r, 4, F.lane); continue; } r -= 4 * C_W1;
          if (r < 4 * C_W2) { const int l = r / C_W2; r -= l * C_W2; p0_transpose_item<0>(a.in[I_AW2] + (size_t)l * 256 * 128, 256, 128, (bf16*)(ws + WS_WC2 + l * SZ_WC2), scr, r, 2, F.lane); continue; } r -= 4 * C_W2;
          { const int l = r / C_WG; r -= l * C_WG; p0_transpose_item<3, 2>(a.in[I_AWIN] + (size_t)l * D_ * NIN, D_, NIN, (bf16*)(ws + WS_WG + l * SZ_WG), scr, r, 1, F.lane); }
      } }
}

struct NormRow { f32x4 x[8]; bf16x8 y[4]; };
struct NormArgs { const void* xin; const bf16* y; const float* gate; const float* ng_y; void* xout; const float* ng_h; const float* sh; const float* sc; bf16* h; const float* ng_k; const float* ksh; const float* ksc; bf16* hk; };
__device__ __forceinline__ void bf8_to_f32(const bf16x8& v, f32x4& a, f32x4& b) { const u32x4 w = *reinterpret_cast<const u32x4*>(&v);
    a = (f32x4){__uint_as_float(w.x << 16), __uint_as_float(w.x & 0xffff0000u), __uint_as_float(w.y << 16), __uint_as_float(w.y & 0xffff0000u)};
    b = (f32x4){__uint_as_float(w.z << 16), __uint_as_float(w.z & 0xffff0000u), __uint_as_float(w.w << 16), __uint_as_float(w.w & 0xffff0000u)}; }
template <bool XIN16> __device__ __forceinline__ void norm_load(NormRow& R, const NormArgs& A, int m, int lane) {
    const size_t ro = (size_t)m * D_ + 8 * lane;
    if (XIN16) {
#pragma unroll
        for (int j = 0; j < 4; ++j) { const bf16x8 v = *(const bf16x8*)((const bf16*)A.xin + ro + 512 * j); *reinterpret_cast<bf16x8*>(&R.x[2 * j]) = v; }
    } else {
#pragma unroll
        for (int j = 0; j < 4; ++j) { R.x[2 * j] = *(const f32x4*)((const float*)A.xin + ro + 512 * j); R.x[2 * j + 1] = *(const f32x4*)((const float*)A.xin + ro + 512 * j + 4); }
    }
    if (A.y) {
#pragma unroll
        for (int j = 0; j < 4; ++j) R.y[j] = *(const bf16x8*)(A.y + ro + 512 * j);
    }
}
template <bool XIN16, bool XOUT16> __device__ __forceinline__ void norm_process(NormRow& R, const NormArgs& A, int m, int lane) {
    const int b = m >> 12; const size_t ro = (size_t)m * D_ + 8 * lane;
    if (XIN16) {
#pragma unroll
        for (int j = 0; j < 4; ++j) { const bf16x8 v = *reinterpret_cast<const bf16x8*>(&R.x[2 * j]); bf8_to_f32(v, R.x[2 * j], R.x[2 * j + 1]); }
    }
    if (A.y) {
        f32x4 yv[8]; float ss = 0.f;
#pragma unroll
        for (int j = 0; j < 4; ++j) bf8_to_f32(R.y[j], yv[2 * j], yv[2 * j + 1]);
#pragma unroll
        for (int j = 0; j < 8; ++j) ss += (yv[j][0] * yv[j][0] + yv[j][1] * yv[j][1]) + (yv[j][2] * yv[j][2] + yv[j][3] * yv[j][3]);
        const float r = 1.0f / sqrtf(wave_sum(ss) * (1.0f / D_) + EPS);
#pragma unroll
        for (int j = 0; j < 8; ++j) { const int col = 8 * lane + 512 * (j >> 1) + 4 * (j & 1); const f32x4 gv = *(const f32x4*)(A.gate + (size_t)b * 12288 + col), nv = *(const f32x4*)(A.ng_y + col);
            R.x[j] = R.x[j] + gv * ((yv[j] * r) * nv);
            if (!XOUT16) *(f32x4*)((float*)A.xout + ro + 512 * (j >> 1) + 4 * (j & 1)) = R.x[j]; }
        if (XOUT16) {
#pragma unroll
            for (int j = 0; j < 4; ++j) { u32x4 w; w.x = cvtpk(R.x[2 * j][0], R.x[2 * j][1]); w.y = cvtpk(R.x[2 * j][2], R.x[2 * j][3]); w.z = cvtpk(R.x[2 * j + 1][0], R.x[2 * j + 1][1]); w.w = cvtpk(R.x[2 * j + 1][2], R.x[2 * j + 1][3]);
                *(u32x4*)((bf16*)A.xout + ro + 512 * j) = w;
                bf8_to_f32(*reinterpret_cast<const bf16x8*>(&w), R.x[2 * j], R.x[2 * j + 1]); }
        }
    }
    if (A.h || A.hk) {
        float ss = 0.f;
#pragma unroll
        for (int j = 0; j < 8; ++j) ss += (R.x[j][0] * R.x[j][0] + R.x[j][1] * R.x[j][1]) + (R.x[j][2] * R.x[j][2] + R.x[j][3] * R.x[j][3]);
        const float r = 1.0f / sqrtf(wave_sum(ss) * (1.0f / D_) + EPS);
        if (A.h) {
#pragma unroll
            for (int j = 0; j < 4; ++j) { const int col = 8 * lane + 512 * j; u32x4 w;
                { const f32x4 nv = *(const f32x4*)(A.ng_h + col), sv = *(const f32x4*)(A.sc + (size_t)b * 12288 + col), hv = *(const f32x4*)(A.sh + (size_t)b * 12288 + col);
                  const f32x4 o = ((R.x[2 * j] * r) * nv) * (sv + 1.0f) + hv; w.x = cvtpk(o[0], o[1]); w.y = cvtpk(o[2], o[3]); }
                { const f32x4 nv = *(const f32x4*)(A.ng_h + col + 4), sv = *(const f32x4*)(A.sc + (size_t)b * 12288 + col + 4), hv = *(const f32x4*)(A.sh + (size_t)b * 12288 + col + 4);
                  const f32x4 o = ((R.x[2 * j + 1] * r) * nv) * (sv + 1.0f) + hv; w.z = cvtpk(o[0], o[1]); w.w = cvtpk(o[2], o[3]); }
                *(u32x4*)(A.h + ro + 512 * j) = w; }
        }
        if (A.hk) {
#pragma unroll
            for (int j = 0; j < 4; ++j) { const int col = 8 * lane + 512 * j; u32x4 w;
                { const f32x4 nv = *(const f32x4*)(A.ng_k + col), sv = *(const f32x4*)(A.ksc + (size_t)b * 4096 + col), hv = *(const f32x4*)(A.ksh + (size_t)b * 4096 + col);
                  const f32x4 o = ((R.x[2 * j] * r) * nv) * (sv + 1.0f) + hv; w.x = cvtpk(o[0], o[1]); w.y = cvtpk(o[2], o[3]); }
                { const f32x4 nv = *(const f32x4*)(A.ng_k + col + 4), sv = *(const f32x4*)(A.ksc + (size_t)b * 4096 + col + 4), hv = *(const f32x4*)(A.ksh + (size_t)b * 4096 + col + 4);
                  const f32x4 o = ((R.x[2 * j + 1] * r) * nv) * (sv + 1.0f) + hv; w.z = cvtpk(o[0], o[1]); w.w = cvtpk(o[2], o[3]); }
                *(u32x4*)(A.hk + ro + 512 * j) = w; }
        }
    }
}
template <bool XIN16, bool XOUT16> __device__ __forceinline__ void norm_process_r(NormRow& R, const NormArgs& A, int m, int lane, const f32x4 (&pa)[8], const f32x4 (&pm)[8], const LAS float* lv) {
    const int b = m >> 12; const size_t ro = (size_t)m * D_ + 8 * lane;
    if (XIN16) {
#pragma unroll
        for (int j = 0; j < 4; ++j) { const bf16x8 v = *reinterpret_cast<const bf16x8*>(&R.x[2 * j]); bf8_to_f32(v, R.x[2 * j], R.x[2 * j + 1]); }
    }
    if (A.y) {
        f32x4 yv[8]; float ss = 0.f;
#pragma unroll
        for (int j = 0; j < 4; ++j) bf8_to_f32(R.y[j], yv[2 * j], yv[2 * j + 1]);
#pragma unroll
        for (int j = 0; j < 8; ++j) ss += (yv[j][0] * yv[j][0] + yv[j][1] * yv[j][1]) + (yv[j][2] * yv[j][2] + yv[j][3] * yv[j][3]);
        const float r = 1.0f / sqrtf(wave_sum(ss) * (1.0f / D_) + EPS);
#pragma unroll
        for (int j = 0; j < 8; ++j) { R.x[j] = R.x[j] + pa[j] * (yv[j] * r);
            if (!XOUT16) *(f32x4*)((float*)A.xout + ro + 512 * (j >> 1) + 4 * (j & 1)) = R.x[j]; }
        if (XOUT16) {
#pragma unroll
            for (int j = 0; j < 4; ++j) { u32x4 w; w.x = cvtpk(R.x[2 * j][0], R.x[2 * j][1]); w.y = cvtpk(R.x[2 * j][2], R.x[2 * j][3]); w.z = cvtpk(R.x[2 * j + 1][0], R.x[2 * j + 1][1]); w.w = cvtpk(R.x[2 * j + 1][2], R.x[2 * j + 1][3]);
                *(u32x4*)((bf16*)A.xout + ro + 512 * j) = w;
                bf8_to_f32(*reinterpret_cast<const bf16x8*>(&w), R.x[2 * j], R.x[2 * j + 1]); }
        }
    }
    if (A.h || A.hk) {
        float ss = 0.f;
#pragma unroll
        for (int j = 0; j < 8; ++j) ss += (R.x[j][0] * R.x[j][0] + R.x[j][1] * R.x[j][1]) + (R.x[j][2] * R.x[j][2] + R.x[j][3] * R.x[j][3]);
        const float r = 1.0f / sqrtf(wave_sum(ss) * (1.0f / D_) + EPS);
        if (A.h) {
#pragma unroll
            for (int j = 0; j < 4; ++j) { u32x4 w; const LAS float* shp = lv + 8 * lane + 512 * j;
                { const f32x4 o = (R.x[2 * j] * r) * pm[2 * j] + *(const LAS f32x4*)shp; w.x = cvtpk(o[0], o[1]); w.y = cvtpk(o[2], o[3]); }
                { const f32x4 o = (R.x[2 * j + 1] * r) * pm[2 * j + 1] + *(const LAS f32x4*)(shp + 4); w.z = cvtpk(o[0], o[1]); w.w = cvtpk(o[2], o[3]); }
                *(u32x4*)(A.h + ro + 512 * j) = w; }
        }
        if (A.hk) {
#pragma unroll
            for (int j = 0; j < 4; ++j) { const int col = 8 * lane + 512 * j; u32x4 w;
                { const f32x4 o = (R.x[2 * j] * r) * *(const LAS f32x4*)(lv + 2048 + col) + *(const LAS f32x4*)(lv + 4096 + col); w.x = cvtpk(o[0], o[1]); w.y = cvtpk(o[2], o[3]); }
                { const f32x4 o = (R.x[2 * j + 1] * r) * *(const LAS f32x4*)(lv + 2048 + col + 4) + *(const LAS f32x4*)(lv + 4096 + col + 4); w.z = cvtpk(o[0], o[1]); w.w = cvtpk(o[2], o[3]); }
                *(u32x4*)(A.hk + ro + 512 * j) = w; }
        }
    }
}
template <bool XIN16, bool XOUT16>
__device__ __forceinline__ void norm_phase(Frame& F, const void* xin, const bf16* y, const float* gate, const float* ng_y, void* xout,
                                           const float* ng_h, const float* sh, const float* sc, bf16* h,
                                           const float* ng_k, const float* ksh, const float* ksc, bf16* hk) {
    const NormArgs A{xin, y, gate, ng_y, xout, ng_h, sh, sc, h, ng_k, ksh, ksc, hk};
    const int gw = blockIdx.x * NWAVES + F.wave, NGW = F.G * NWAVES, lane = F.lane;
    if (F.G == 256) {
        const int m0 = ((((int)blockIdx.x & 7) * 32 + ((int)blockIdx.x >> 3)) * NWAVES + F.wave) * 8, b = m0 >> 12;
        LAS float* lv = (LAS float*)F.lds;
        { const int c4 = 4 * F.tid;
          if (h) *(LAS f32x4*)(lv + c4) = *(const f32x4*)(sh + (size_t)b * 12288 + c4);
          if (hk) { *(LAS f32x4*)(lv + 2048 + c4) = *(const f32x4*)(ng_k + c4) * (*(const f32x4*)(ksc + (size_t)b * 4096 + c4) + 1.0f); *(LAS f32x4*)(lv + 4096 + c4) = *(const f32x4*)(ksh + (size_t)b * 4096 + c4); } }
        __syncthreads();
        f32x4 pa[8], pm[8];
#pragma unroll
        for (int j = 0; j < 8; ++j) { const int col = 8 * lane + 512 * (j >> 1) + 4 * (j & 1);
            pa[j] = y ? *(const f32x4*)(gate + (size_t)b * 12288 + col) * *(const f32x4*)(ng_y + col) : (f32x4){0.f, 0.f, 0.f, 0.f};
            pm[j] = h ? *(const f32x4*)(ng_h + col) * (*(const f32x4*)(sc + (size_t)b * 12288 + col) + 1.0f) : (f32x4){0.f, 0.f, 0.f, 0.f};
            }
        NormRow RA, RB;
        norm_load<XIN16>(RA, A, m0, lane);
#pragma unroll 1
        for (int k = 0; k < 8; k += 2) {
            norm_load<XIN16>(RB, A, m0 + k + 1, lane);
            norm_process_r<XIN16, XOUT16>(RA, A, m0 + k, lane, pa, pm, lv);
            if (k + 2 < 8) norm_load<XIN16>(RA, A, m0 + k + 2, lane);
            norm_process_r<XIN16, XOUT16>(RB, A, m0 + k + 1, lane, pa, pm, lv);
        }
        __syncthreads();
        return;
    }
    NormRow RA, RB;
    if (gw < M_) norm_load<XIN16>(RA, A, gw, lane);
    for (int m = gw; m < M_; m += 2 * NGW) {
        const int m2 = m + NGW, m3 = m + 2 * NGW;
        if (m2 < M_) norm_load<XIN16>(RB, A, m2, lane);
        norm_process<XIN16, XOUT16>(RA, A, m, lane);
        if (m3 < M_) norm_load<XIN16>(RA, A, m3, lane);
        if (m2 < M_) norm_process<XIN16, XOUT16>(RB, A, m2, lane);
    }
}

__device__ __forceinline__ void gate_phase(Frame& F, const bf16* H, const bf16* WG, const float* gate_b, float* GATES) {
    LAS float* red = (LAS float*)F.lds;
    const int r = F.lane & 31, hh = F.lane >> 5, w = F.wave, rt = w >> 2, kq = w & 3, wrow = F.lane >> 3, wpc = F.lane & 7;
    LAS char* abuf = (LAS char*)F.lds + 65536 + w * 4608;
    for (int it = blockIdx.x; it < M_ / 64; it += F.G) {
        const int row0 = it * 64;
        const bf16* ap = H + (size_t)(row0 + 32 * rt + wrow) * D_ + kq * 512 + 8 * wpc;
        const bf16* bp = WG + ((size_t)(kq * 8) * 4 * 64 + F.lane) * 8;
        f32x16 a0 = {}, a1 = {};
#define GT_LD(S, ch) bf16x8 S##_a[4], S##_p[4], S##_q[4]; _Pragma("unroll") for (int j = 0; j < 4; ++j) { S##_a[j] = *(const bf16x8*)(ap + (size_t)(8 * j) * D_ + 64 * (ch)); \
            S##_p[j] = *(const bf16x8*)(bp + ((size_t)(ch) * 4 + j) * 512); S##_q[j] = *(const bf16x8*)(bp + (size_t)32 * 4 * 512 + ((size_t)(ch) * 4 + j) * 512); }
#define GT_MM(S) { _Pragma("unroll") for (int j = 0; j < 4; ++j) *(LAS bf16x8*)(abuf + (wrow + 8 * j) * 144 + wpc * 16) = S##_a[j]; \
            bf16x8 af[4]; _Pragma("unroll") for (int j = 0; j < 4; ++j) af[j] = *(const LAS bf16x8*)(abuf + r * 144 + (4 * hh + j) * 16); \
            _Pragma("unroll") for (int j = 0; j < 4; ++j) { a0 = __builtin_amdgcn_mfma_f32_32x32x16_bf16(af[j], S##_p[j], a0, 0, 0, 0); a1 = __builtin_amdgcn_mfma_f32_32x32x16_bf16(af[j], S##_q[j], a1, 0, 0, 0); } }
        GT_LD(c0, 0) GT_LD(c1, 1)
        GT_LD(c2, 2) GT_MM(c0) GT_LD(c3, 3) GT_MM(c1) GT_LD(c4, 4) GT_MM(c2) GT_LD(c5, 5) GT_MM(c3) GT_LD(c6, 6) GT_MM(c4) GT_LD(c7, 7) GT_MM(c5) GT_MM(c6) GT_MM(c7)
#undef GT_LD
#undef GT_MM
#pragma unroll
        for (int i = 0; i < 16; ++i) { red[((w * 2 + 0) * 16 + i) * 64 + F.lane] = a0[i]; red[((w * 2 + 1) * 16 + i) * 64 + F.lane] = a1[i]; }
        __syncthreads();
        for (int e = F.tid; e < 4096; e += NTHR) { const int ln = e & 63, i = (e >> 6) & 15, ct = (e >> 10) & 1, rt2 = e >> 11;
            float v = 0.f;
#pragma unroll
            for (int q = 0; q < 4; ++q) v += red[(((rt2 * 4 + q) * 2 + ct) * 16 + i) * 64 + ln];
            const int col = 32 * ct + (ln & 31), row = row0 + 32 * rt2 + (i & 3) + 8 * (i >> 2) + 4 * (ln >> 5);
            if (col < 48) GATES[(size_t)row * 48 + col] = 1.0f / (1.0f + __expf(-(v + gate_b[col]))); }
        __syncthreads();
    }
}

__device__ __forceinline__ void compress_phase(Frame& F, const bf16* KV6, const bf16* WC1, const bf16* WC2, const float* PEB, bf16* KCMP) {
    LAS char* ldsb = (LAS char*)F.lds;
    LAS bf16* Hs = (LAS bf16*)F.lds;
    const int r = F.lane & 31, hh = F.lane >> 5, w = F.wave;
    for (int u = blockIdx.x; u < 256; u += F.G) {
        const int t = u >> 7, b = (u >> 5) & 3, g = (u >> 3) & 3, n0 = (u & 7) * 32;
        const bf16* src = KV6 + (size_t)t * M_ * 512 + (size_t)b * S_ * 512 + g * 128;
        { bf16x8 v[17];
#pragma unroll
          for (int i = 0; i < 17; ++i) { const int q = F.tid + 512 * i, row = q >> 4, c = q & 15; int tok = 16 * n0 + row; tok = tok > S_ - 1 ? S_ - 1 : tok;
              if (q < 528 * 16) v[i] = *(const bf16x8*)(src + (size_t)tok * 512 + c * 8); }
#pragma unroll
          for (int i = 0; i < 17; ++i) { const int q = F.tid + 512 * i, row = q >> 4, c = q & 15;
              if (q < 528 * 16) *(LAS bf16x8*)(ldsb + row * 256 + ((c ^ ((row >> 4) & 15)) << 4)) = v[i]; } }
        __syncthreads();
        const bf16* wfrag = WC1 + (size_t)t * 256 * 4096 + ((size_t)w * 256 * 64 + F.lane) * 8;
        f32x16 acc = {};
        bf16x8 b0[8], b1[8];
#pragma unroll
        for (int dd = 0; dd < 8; ++dd) b0[dd] = *(const bf16x8*)(wfrag + (size_t)dd * 512);
#define CMP_STEP(LT, BC, BN) do { const int lt_ = (LT); \
            if (lt_ + 1 < 32) { _Pragma("unroll") for (int dd = 0; dd < 8; ++dd) BN[dd] = *(const bf16x8*)(wfrag + (size_t)((lt_ + 1) * 8 + dd) * 512); } \
            const int row = 16 * r + lt_; const LAS char* arow = ldsb + row * 256; const int key = (row >> 4) & 15; \
            _Pragma("unroll") for (int dd = 0; dd < 8; ++dd) { const bf16x8 af = *(const LAS bf16x8*)(arow + (((2 * dd + hh) ^ key) << 4)); \
                acc = __builtin_amdgcn_mfma_f32_32x32x16_bf16(af, BC[dd], acc, 0, 0, 0); } } while (0)
        for (int lt = 0; lt < 32; lt += 2) { CMP_STEP(lt, b0, b1); CMP_STEP(lt + 1, b1, b0); }
#undef CMP_STEP
        __syncthreads();
        const float pb = PEB[t * 256 + 32 * w + r];
#pragma unroll
        for (int i = 0; i < 16; ++i) { const int row = (i & 3) + 8 * (i >> 2) + 4 * hh; const float x = acc[i] + pb;
            const float u2 = 1.5957691216057308f * (x + 0.044715f * x * x * x);
            const float gl = x / (1.0f + __expf(-u2));
            Hs[row * 264 + 32 * w + r] = (bf16)(cvtpk(gl, 0.f) & 0xffffu); }
        __syncthreads();
        if (w < 4) {
            f32x16 a2 = {};
            const bf16* w2row = WC2 + (size_t)t * 128 * 256 + (size_t)(32 * w + r) * 256 + 8 * hh;
#pragma unroll
            for (int ks = 0; ks < 16; ++ks) {
                const bf16x8 af = *(const LAS bf16x8*)(Hs + r * 264 + 16 * ks + 8 * hh);
                const bf16x8 bfr = *(const bf16x8*)(w2row + 16 * ks);
                a2 = __builtin_amdgcn_mfma_f32_32x32x16_bf16(af, bfr, a2, 0, 0, 0);
            }
            bf16* dst = KCMP + ((size_t)(t * 16 + b * 4 + g) * NCP) * HD + 32 * w + r;
#pragma unroll
            for (int i = 0; i < 16; ++i) { const int n = n0 + (i & 3) + 8 * (i >> 2) + 4 * hh;
                dst[(size_t)n * HD] = (n < 255) ? (bf16)(cvtpk(a2[i], 0.f) & 0xffffu) : (bf16)0; }
        }
        __syncthreads();
    }
}

#define KSWZ(row, colB) ((row) * 256 + ((colB) ^ (((row) & 7) << 4)))
constexpr int SHM_K = 16384, SHM_V = 16384;
__device__ __forceinline__ int v_st(int k, int c) { const int kk = (k & ~0xC) | ((k & 4) << 1) | ((k & 8) >> 1); return ((kk >> 3) * 4 + (c >> 5)) * 512 + ((kk & 7) * 32 + (c & 31)) * 2; }
__device__ __forceinline__ int v_rd_base(int lane) { return ((lane & 3) << 3) | (((lane >> 2) & 3) << 6) | (((lane >> 4) & 1) << 5) | (((lane >> 5) & 1) << 8); }
constexpr int v_rd_off(int d0, int ks, int half) { return d0 * 512 + ks * 4096 + half * 2048; }
__device__ __forceinline__ int crow(int r, int hi) { return (r & 3) + 8 * (r >> 2) + 4 * hi; }
__device__ __forceinline__ float xhalf(float v, int hi) {
    auto rr = __builtin_amdgcn_permlane32_swap(__float_as_uint(v), __float_as_uint(v), false, false);
    return __uint_as_float(hi ? rr[0] : rr[1]);
}
struct StageRegs { bf16x8 k0, k1, v0, v1; };
template <bool DOV> __device__ __forceinline__ void stage_load(StageRegs& s, const bf16* K, const bf16* V, int stride, int key0, int sr, int sc) {
    s.k0 = *(const bf16x8*)(K + (size_t)(key0 + sr) * stride + sc); s.k1 = *(const bf16x8*)(K + (size_t)(key0 + 32 + sr) * stride + sc);
    if (DOV) { s.v0 = *(const bf16x8*)(V + (size_t)(key0 + sr) * stride + sc); s.v1 = *(const bf16x8*)(V + (size_t)(key0 + 32 + sr) * stride + sc); }
}
template <bool DOV> __device__ __forceinline__ void stage_write(const StageRegs& s, LAS char* Kb, LAS char* Vb, int sr, int sc) {
    const int kws = KSWZ(sr, sc * 2);
    *(LAS bf16x8*)(Kb + kws) = s.k0; *(LAS bf16x8*)(Kb + kws + 32 * 256) = s.k1;
    if (DOV) { *(LAS bf16x8*)(Vb + v_st(sr, sc)) = s.v0; *(LAS bf16x8*)(Vb + v_st(32 + sr, sc)) = s.v1; }
}
__device__ __forceinline__ void qkt(f32x16& p0, f32x16& p1, const LAS char* Kb, int r32, int hi, const bf16x8 (&qr)[8]) {
    p0 = f32x16{}; p1 = f32x16{};
    const LAS char* kb[4];
#pragma unroll
    for (int dd = 0; dd < 4; ++dd) kb[dd] = Kb + KSWZ(r32, (dd * 16 + hi * 8) * 2);
#define QK_RD(B, d0a) const bf16x8 B##0 = *(const LAS bf16x8*)(kb[(d0a) & 3] + ((d0a) >> 2) * 128), B##1 = *(const LAS bf16x8*)(kb[(d0a) & 3] + ((d0a) >> 2) * 128 + 32 * 256), \
                      B##2 = *(const LAS bf16x8*)(kb[((d0a) + 1) & 3] + (((d0a) + 1) >> 2) * 128), B##3 = *(const LAS bf16x8*)(kb[((d0a) + 1) & 3] + (((d0a) + 1) >> 2) * 128 + 32 * 256)
#define QK_MM(B, d0a) do { p0 = __builtin_amdgcn_mfma_f32_32x32x16_bf16(B##0, qr[d0a], p0, 0, 0, 0); p1 = __builtin_amdgcn_mfma_f32_32x32x16_bf16(B##1, qr[d0a], p1, 0, 0, 0); \
                           p0 = __builtin_amdgcn_mfma_f32_32x32x16_bf16(B##2, qr[(d0a) + 1], p0, 0, 0, 0); p1 = __builtin_amdgcn_mfma_f32_32x32x16_bf16(B##3, qr[(d0a) + 1], p1, 0, 0, 0); } while (0)
    QK_RD(ka, 0); QK_RD(kc, 2); SBAR();
    QK_MM(ka, 0); QK_RD(ke, 4); SBAR();
    QK_MM(kc, 2); QK_RD(kg, 6); SBAR();
    QK_MM(ke, 4); SBAR();
    QK_MM(kg, 6);
#undef QK_RD
#undef QK_MM
}
__device__ __forceinline__ void pack_p(const f32x16& p0, const f32x16& p1, bf16x8& pa0, bf16x8& pa1, bf16x8& pa2, bf16x8& pa3) {
#define PK4(P, B_, OUT) do { unsigned a0 = cvtpk(P[B_+0], P[B_+1]), a1 = cvtpk(P[B_+2], P[B_+3]);                          \
        unsigned b0 = cvtpk(P[B_+4], P[B_+5]), b1 = cvtpk(P[B_+6], P[B_+7]);                                             \
        auto r0 = __builtin_amdgcn_permlane32_swap(a0, b0, false, false); auto r1 = __builtin_amdgcn_permlane32_swap(a1, b1, false, false); \
        u32x4 w = {r0[0], r1[0], r0[1], r1[1]}; OUT = *reinterpret_cast<bf16x8*>(&w); } while (0)
    PK4(p0, 0, pa0); PK4(p0, 8, pa1); PK4(p1, 0, pa2); PK4(p1, 8, pa3);
#undef PK4
}
__device__ __forceinline__ void pv_tile(f32x16 (&o)[4], int vb, bf16x8 pa0, bf16x8 pa1, bf16x8 pa2, bf16x8 pa3) {
    const LAS char* vp = (const LAS char*)(uintptr_t)(unsigned)vb;
#define TRRD(off) __builtin_amdgcn_ds_read_tr16_b64_v4i16((LAS s16x4*)(vp + (off)))
#define TRB(off) __builtin_shufflevector(TRRD(off), TRRD((off) + 2048), 0, 1, 2, 3, 4, 5, 6, 7)
#define PV_D0(d0) do { constexpr int b_ = v_rd_off(d0, 0, 0); \
        const bf16x8 v0 = TRB(b_), v1 = TRB(b_ + 4096), v2 = TRB(b_ + 8192), v3 = TRB(b_ + 12288); \
        o[d0] = __builtin_amdgcn_mfma_f32_32x32x16_bf16(pa0, v0, o[d0], 0, 0, 0);   \
        o[d0] = __builtin_amdgcn_mfma_f32_32x32x16_bf16(pa1, v1, o[d0], 0, 0, 0);   \
        o[d0] = __builtin_amdgcn_mfma_f32_32x32x16_bf16(pa2, v2, o[d0], 0, 0, 0);   \
        o[d0] = __builtin_amdgcn_mfma_f32_32x32x16_bf16(pa3, v3, o[d0], 0, 0, 0); } while (0)
    PV_D0(0); PV_D0(1); PV_D0(2); PV_D0(3);
#undef PV_D0
#undef TRB
#undef TRRD
}

template <int MODE, bool IMP, bool DOPV>
__device__ __forceinline__ void attn_pass(Frame& F, LAS char* lds, const bf16* K, const bf16* V, int stride, unsigned long long tiles,
                                          const bf16x8 (&qr)[8], int klo, int khi, int u_klo_max, int u_khi_min, unsigned long long bmask, float& m, float& l, float rl, float gate,
                                          f32x16 (&o)[4], LAS float* impA, LAS float* impB, int tokl, LAS float* alw) {
    if (tiles == 0ull) return;
    constexpr bool NEEDV = (MODE == 2) || (MODE == 1 && DOPV);
    int tid_ = F.tid; asm volatile("" : "+v"(tid_));
    const int lane = tid_ & 63, r32 = lane & 31, hi = lane >> 5, sr = tid_ >> 4, sc = (tid_ & 15) * 8;
    const int vb0 = (int)(uintptr_t)(lds + 2 * SHM_K) + v_rd_base(lane);
    const float NEG = -__builtin_inff();
    StageRegs st;
    int j = __builtin_ctzll(tiles); tiles &= tiles - 1;
    stage_load<NEEDV>(st, K, V, stride, j * 64, sr, sc);
    stage_write<NEEDV>(st, lds, lds + 2 * SHM_K, sr, sc);
    __syncthreads();
    int buf = 0;
    for (;;) {
        const bool more = tiles != 0ull; int jn = 0;
        if (more) { jn = __builtin_ctzll(tiles); tiles &= tiles - 1; stage_load<NEEDV>(st, K, V, stride, jn * 64, sr, sc); }
        f32x16 p0, p1;
        qkt(p0, p1, lds + buf * SHM_K, r32, hi, qr);
        const bool bit = (bmask >> j) & 1ull;
        if (j * 64 < u_klo_max || j * 64 + 63 > u_khi_min) {
            const int kb = j * 64 + 4 * hi;
#pragma unroll
            for (int r = 0; r < 16; ++r) { const int k0 = kb + (r & 3) + 8 * (r >> 2), k1 = k0 + 32;
                if (!(k0 >= klo && k0 <= khi)) p0[r] = NEG;
                if (!(k1 >= klo && k1 <= khi)) p1[r] = NEG; }
        }
        if (MODE == 0 || MODE == 2) {
            float tmax = p0[0];
#pragma unroll
            for (int r = 1; r < 16; ++r) tmax = fmaxf(tmax, p0[r]);
#pragma unroll
            for (int r = 0; r < 16; ++r) tmax = fmaxf(tmax, p1[r]);
            tmax = bit ? tmax : NEG;
            tmax = fmaxf(tmax, xhalf(tmax, hi));
            if (MODE == 0) {
                const float mn = fmaxf(m, tmax), mb = bit ? -mn * C2 : NEG;
                float ps = 0.f;
#pragma unroll
                for (int r = 0; r < 16; ++r) ps += __builtin_amdgcn_exp2f(fmaf(p0[r], C2, mb)) + __builtin_amdgcn_exp2f(fmaf(p1[r], C2, mb));
                ps += xhalf(ps, hi);
                l = l * __builtin_amdgcn_exp2f((m - mn) * C2) + ps; m = mn;
            } else {
                if (!__all((tmax - m) * SCALE <= 8.0f)) {
                    const float mn = fmaxf(m, tmax), alpha = __builtin_amdgcn_exp2f((m - mn) * C2);
                    l *= alpha; m = mn;
                    if (hi == 0) alw[r32] = alpha;
#pragma unroll
                    for (int r = 0; r < 16; ++r) { const float al = alw[crow(r, hi)];
#pragma unroll
                        for (int d0 = 0; d0 < 4; ++d0) o[d0][r] *= al; }
                }
                const float mb = bit ? -m * C2 : NEG;
                float ps = 0.f;
#pragma unroll
                for (int r = 0; r < 16; ++r) { p0[r] = __builtin_amdgcn_exp2f(fmaf(p0[r], C2, mb)); p1[r] = __builtin_amdgcn_exp2f(fmaf(p1[r], C2, mb)); ps += p0[r] + p1[r]; }
                ps += xhalf(ps, hi);
                l += ps;
                bf16x8 pa0, pa1, pa2, pa3;
                pack_p(p0, p1, pa0, pa1, pa2, pa3);
                pv_tile(o, vb0 + buf * SHM_V, pa0, pa1, pa2, pa3);
            }
        } else {
            const float mb = bit ? -m * C2 : NEG;
#pragma unroll
            for (int r = 0; r < 16; ++r) { p0[r] = __builtin_amdgcn_exp2f(fmaf(p0[r], C2, mb)) * rl; p1[r] = __builtin_amdgcn_exp2f(fmaf(p1[r], C2, mb)) * rl; }
            if (IMP) {
#pragma unroll
                for (int pi = 0; pi < 2; ++pi)
#pragma unroll
                    for (int q = 0; q < 4; ++q) {
                        float qs, last;
                        if (pi == 0) { qs = (p0[4 * q] + p0[4 * q + 1]) + (p0[4 * q + 2] + p0[4 * q + 3]); last = p0[4 * q + 3]; }
                        else { qs = (p1[4 * q] + p1[4 * q + 1]) + (p1[4 * q + 2] + p1[4 * q + 3]); last = p1[4 * q + 3]; }
                        qs += lx1(qs); qs += lx2(qs); last += lx1(last); last += lx2(last);
                        const int mb_ = 16 * j + 8 * pi + 2 * q + hi;
                        if ((r32 & 3) == 0) { impA[tokl * 64 + mb_] = qs; if (mb_ + 1 < 64) impB[tokl * 64 + mb_ + 1] = last; }
                    }
            }
            if (DOPV) {
#pragma unroll
                for (int r = 0; r < 16; ++r) { p0[r] *= gate; p1[r] *= gate; }
                bf16x8 pa0, pa1, pa2, pa3;
                pack_p(p0, p1, pa0, pa1, pa2, pa3);
                pv_tile(o, vb0 + buf * SHM_V, pa0, pa1, pa2, pa3);
            }
        }
        if (more) stage_write<NEEDV>(st, lds + (buf ^ 1) * SHM_K, lds + 2 * SHM_K + (buf ^ 1) * SHM_V, sr, sc);
        __syncthreads();
        if (!more) break;
        j = jn; buf ^= 1;
    }
}

constexpr int NSA_IMP_OFF = 65536, NSA_MASK_OFF = 65536 + 32768, NSA_ALW_OFF = NSA_MASK_OFF + 1024, NSA_PK2_OFF = 106496;
__device__ __forceinline__ void nsa_attn_phase(Frame& F, const bf16* Q, const bf16* KV6, const bf16* KCMP, const float* GATES, bf16* O, float* STASH) {
    LAS char* lds = (LAS char*)F.lds;
    LAS float* impA = (LAS float*)(lds + NSA_IMP_OFF); LAS float* impB = impA + 4096;
    LAS unsigned long long* MASK = (LAS unsigned long long*)(lds + NSA_MASK_OFF);
    const int lane = F.lane, w = F.wave, r32 = lane & 31, hi = lane >> 5;
    LAS float* alw = (LAS float*)(lds + NSA_ALW_OFF) + w * 32;
    (void)STASH;
    if (w >= 4) __builtin_amdgcn_s_setprio(1);
    for (int i = 0;; ++i) {
        int qt, bg;
        if (F.G == 256) {
            if (i >= 4) break;
            const int x = blockIdx.x & 7, k = blockIdx.x >> 3;
            bg = x + 8 * (i >> 1); qt = (i & 1) ? k : 63 - k;
        } else {
            const int idx = i * F.G + ((i & 1) ? (F.G - 1 - (int)blockIdx.x) : (int)blockIdx.x);
            if (idx >= 1024) break;
            qt = 63 - (idx >> 4); bg = idx & 15;
        }
        const int b = bg >> 2, g = bg & 3, t0 = qt * 64;
        const int tw0 = t0 + 8 * w;
        const int tokl = 8 * w + (r32 >> 2), t = t0 + tokl, head = 4 * g + (r32 & 3);
        const size_t rowQ = (size_t)b * S_ + t;
        bf16x8 qr[8];
#pragma unroll
        for (int d0 = 0; d0 < 8; ++d0) qr[d0] = *(const bf16x8*)(Q + rowQ * D_ + head * HD + d0 * 16 + hi * 8);
        float g_all[3]; { const float* gp_ = GATES + rowQ * 48 + head * 3; g_all[0] = gp_[0]; g_all[1] = gp_[1]; g_all[2] = gp_[2]; }
#define NSA_GATE(k) (g_all[k])
        for (int e = F.tid; e < 8192; e += NTHR) impA[e] = 0.f;
        __syncthreads();
        f32x16 o[4] = {};
        const size_t kvb = (size_t)b * S_ * 512 + g * 128, TS = (size_t)M_ * 512;
        { const int nvalid = t >= 31 ? (t - 15) >> 4 : 0, ntc = (((t0 + 48) >> 4) + 63) >> 6;
          const int nv_min = tw0 >= 31 ? (tw0 - 15) >> 4 : 0;
          const unsigned long long tc = (1ull << ntc) - 1ull;
          const bf16* Kc = KCMP + (size_t)bg * NCP * HD; const bf16* Vc = KCMP + (size_t)(16 + bg) * NCP * HD;
          float m_c = -1e30f, l_c = 0.f;
          attn_pass<0, false, false>(F, lds, Kc, Vc, HD, tc, qr, 0, nvalid - 1, 0, nv_min - 1, ~0ull, m_c, l_c, 0.f, 0.f, o, impA, impB, tokl, alw);
          const float rl_c = l_c > 0.f ? 1.0f / l_c : 0.f;
          attn_pass<1, true, true>(F, lds, Kc, Vc, HD, tc, qr, 0, nvalid - 1, 0, nv_min - 1, ~0ull, m_c, l_c, rl_c, NSA_GATE(0), o, impA, impB, tokl, alw); }
        __syncthreads();
        int lnk = F.lane; asm volatile("" : "+v"(lnk));
        { const bool forced = (lnk == 0) || (lnk == qt) || (lnk == qt - 1), avail = lnk <= qt;
          LAS unsigned* kbuf = (LAS unsigned*)(lds + w * 2048);
#pragma unroll
          for (int u = 0; u < 8; ++u) { const int tok = 8 * w + u; const float v = impA[tok * 64 + lnk] + impB[tok * 64 + lnk];
              kbuf[u * 64 + lnk] = forced ? 0xFFFFFFFFu : (avail ? __float_as_uint(v) + 64u : (unsigned)(63 - lnk)); }
#pragma unroll 1
          for (int u = 0; u < 8; ++u) {
              const unsigned key = kbuf[u * 64 + lnk]; int rank = 0;
              const int nq = ((qt > 15 ? qt : 15) >> 2) + 1;
#pragma unroll 4
              for (int q = 0; q < nq; ++q) { const u32x4 o4 = *(const LAS u32x4*)(kbuf + u * 64 + 4 * q);
                  rank += (o4.x > key ? 1 : 0) + (o4.y > key ? 1 : 0) + (o4.z > key ? 1 : 0) + (o4.w > key ? 1 : 0); }
              unsigned long long sel = __ballot(rank < 16);
              if (__builtin_popcount((unsigned)sel) + __builtin_popcount((unsigned)(sel >> 32)) != 16) {
                  unsigned T = 0u;
#pragma unroll 1
                  for (int bit = 30; bit >= 0; --bit) { const unsigned c = T | (1u << bit); const unsigned long long bl = __ballot(key >= c);
                      if (__builtin_popcount((unsigned)bl) + __builtin_popcount((unsigned)(bl >> 32)) >= 16) T = c; }
                  const unsigned long long gt = __ballot(key > T), eq = __ballot(key == T);
                  const int need = 16 - (__builtin_popcount((unsigned)gt) + __builtin_popcount((unsigned)(gt >> 32)));
                  const int pos = (int)__builtin_amdgcn_mbcnt_hi((unsigned)(eq >> 32), __builtin_amdgcn_mbcnt_lo((unsigned)eq, 0u));
                  sel = __ballot(key > T || (key == T && pos < need));
              }
              if (lnk == 0) MASK[8 * w + u] = sel; }
        }
        __syncthreads();
        const unsigned long long ts = (qt == 63) ? ~0ull : ((1ull << (qt + 1)) - 1ull);
#define NSA_PK(k) (*(LAS unsigned*)(lds + ((k) < 16 ? NSA_IMP_OFF + (k) * 2048 : NSA_PK2_OFF + ((k) - 16) * 2048) + stid * 4))
        const unsigned long long mymask0 = MASK[tokl];
        int stid = F.tid; asm volatile("" : "+v"(stid));
#pragma unroll
        for (int d0 = 0; d0 < 4; ++d0)
#pragma unroll
            for (int r2 = 0; r2 < 8; ++r2) NSA_PK(d0 * 8 + r2) = cvtpk(o[d0][2 * r2], o[d0][2 * r2 + 1]);
#pragma unroll
        for (int d0 = 0; d0 < 4; ++d0) o[d0] = f32x16{};
        { const unsigned long long mymask = mymask0;
          const bf16* Ks = KV6 + 2 * TS + kvb; const bf16* Vs = KV6 + 3 * TS + kvb;
          float m = -1e30f, l = 0.f;
          attn_pass<2, false, true>(F, lds, Ks, Vs, 512, ts, qr, 0, t, 0, tw0, mymask, m, l, 0.f, 0.f, o, impA, impB, tokl, alw);
          const float f = l > 0.f ? NSA_GATE(1) / l : 0.f;
          if (hi == 0) alw[r32] = f;
          float al[16];
#pragma unroll
          for (int r = 0; r < 16; ++r) al[r] = alw[crow(r, hi)];
#pragma unroll
          for (int d0 = 0; d0 < 4; ++d0)
#pragma unroll
              for (int r2 = 0; r2 < 8; ++r2) { const unsigned w_ = NSA_PK(d0 * 8 + r2);
                  const float a = o[d0][2 * r2] * al[2 * r2] + __uint_as_float(w_ << 16), c = o[d0][2 * r2 + 1] * al[2 * r2 + 1] + __uint_as_float(w_ & 0xffff0000u);
                  NSA_PK(d0 * 8 + r2) = cvtpk(a, c); }
#pragma unroll
          for (int d0 = 0; d0 < 4; ++d0) o[d0] = f32x16{}; }
        { const bf16* Kw = KV6 + 4 * TS + kvb; const bf16* Vw = KV6 + 5 * TS + kvb;
          const int jlo = qt >= 8 ? qt - 8 : 0; const unsigned long long tw = ts & ~((1ull << jlo) - 1ull);
          float m = -1e30f, l = 0.f;
          attn_pass<2, false, true>(F, lds, Kw, Vw, 512, tw, qr, t - 511, t, tw0 + 7 - 511, tw0, ~0ull, m, l, 0.f, 0.f, o, impA, impB, tokl, alw);
          const float f = l > 0.f ? NSA_GATE(2) / l : 0.f;
          if (hi == 0) alw[r32] = f;
          float al[16];
#pragma unroll
          for (int r = 0; r < 16; ++r) al[r] = alw[crow(r, hi)];
#pragma unroll
          for (int d0 = 0; d0 < 4; ++d0)
#pragma unroll
              for (int r2 = 0; r2 < 8; ++r2) { const unsigned w_ = NSA_PK(d0 * 8 + r2);
                  o[d0][2 * r2] = o[d0][2 * r2] * al[2 * r2] + __uint_as_float(w_ << 16); o[d0][2 * r2 + 1] = o[d0][2 * r2 + 1] * al[2 * r2 + 1] + __uint_as_float(w_ & 0xffff0000u); } }
        int ln2 = F.lane; asm volatile("" : "+v"(ln2)); const int r32s = ln2 & 31, his = ln2 >> 5;
        LAS char* ost = lds + w * 8192;
#pragma unroll
        for (int r = 0; r < 16; ++r) { LAS char* op = ost + crow(r, his) * 256 + r32s * 2;
#pragma unroll
            for (int d0 = 0; d0 < 4; ++d0) { const float v = o[d0][r], vn = lx1(v); if ((r32s & 1) == 0) *(LAS unsigned*)(op + d0 * 64) = cvtpk(v, vn); } }
        { bf16* ob = O + ((size_t)b * S_ + t0 + 8 * w) * D_ + (size_t)(4 * g) * HD + ln2 * 8;
#pragma unroll
          for (int i = 0; i < 8; ++i) { const u32x4 v = *(const LAS u32x4*)(ost + i * 1024 + ln2 * 16); *(u32x4*)(ob + (size_t)i * D_) = v; } }
    }
    __builtin_amdgcn_s_setprio(0);
}

constexpr int SB_DONE_OFF = 65536;
constexpr float SB_EPS = 9.094947e-13f;
__device__ __forceinline__ void sb_attn_phase(Frame& F, const bf16* Q, const bf16* Ksh, const bf16* Vsh, bf16* O) {
    LAS char* lds = (LAS char*)F.lds;
    LAS unsigned* DONE = (LAS unsigned*)(lds + SB_DONE_OFF);
    const int lane = F.lane, w = F.wave, r32 = lane & 31, hi = lane >> 5, sr = F.tid >> 4, sc = (F.tid & 15) * 8;
    const int vb0 = (int)(uintptr_t)(lds + 2 * SHM_K) + v_rd_base(lane);
    if (w >= 4) __builtin_amdgcn_s_setprio(1);
    for (int ui = 0, u0 = blockIdx.x; u0 < 1024; ++ui, u0 += F.G) {
        int u = u0;
        if (F.G == 256) { const int x = blockIdx.x & 7, q = ui * 32 + (blockIdx.x >> 3); u = ((x + 8 * (q >> 4)) << 4) | (q & 15); }
        const int qb = u & 15, bh = u >> 4, b = bh >> 4, h = bh & 15, t0 = qb * 256, rlo = t0 + 32 * w, t = rlo + r32;
        bf16x8 qr[8];
#pragma unroll
        for (int d0 = 0; d0 < 8; ++d0) qr[d0] = *(const bf16x8*)(Q + ((size_t)b * S_ + t) * D_ + h * HD + d0 * 16 + hi * 8);
        const bf16* Kp = Ksh + (size_t)b * S_ * D_ + h * HD; const bf16* Vp = Vsh + (size_t)b * S_ * D_ + h * HD;
        float carry = 1.0f; f32x16 o[4] = {};
        int j = (t0 >> 6) + 3, buf = 0, it = 0;
        StageRegs st;
        stage_load<true>(st, Kp, Vp, D_, j * 64, sr, sc);
        stage_write<true>(st, lds, lds + 2 * SHM_K, sr, sc);
        __syncthreads();
        for (;;) {
            const bool more = j > 0;
            if (more) stage_load<true>(st, Kp, Vp, D_, (j - 1) * 64, sr, sc);
            const int kb = j * 64;
            const bool wdone = __all(carry < SB_EPS);
            if (kb <= rlo + 30 && !wdone) {
                f32x16 p0, p1;
                qkt(p0, p1, lds + buf * SHM_K, r32, hi, qr);
                f32x16 om0, om1; const int kq = kb + 4 * hi;
#pragma unroll
                for (int r = 0; r < 16; ++r) { const int k0 = kq + (r & 3) + 8 * (r >> 2), k1 = k0 + 32;
                    { float z = p0[r] * SCALE; z = fminf(fmaxf(z, -80.f), 80.f); const float e = __builtin_amdgcn_exp2f(-1.4426950408889634f * z), be = __builtin_amdgcn_rcpf(1.0f + e);
                      const bool c = k0 < t; p0[r] = c ? be : 0.f; om0[r] = c ? e * be : 1.0f; }
                    { float z = p1[r] * SCALE; z = fminf(fmaxf(z, -80.f), 80.f); const float e = __builtin_amdgcn_exp2f(-1.4426950408889634f * z), be = __builtin_amdgcn_rcpf(1.0f + e);
                      const bool c = k1 < t; p1[r] = c ? be : 0.f; om1[r] = c ? e * be : 1.0f; } }
                float acc = carry;
#pragma unroll
                for (int uu = 7; uu >= 0; --uu) { const int q = uu & 3;
                    float a0, a1, a2, a3;
                    if (uu >= 4) { a0 = om1[4 * q]; a1 = om1[4 * q + 1]; a2 = om1[4 * q + 2]; a3 = om1[4 * q + 3]; } else { a0 = om0[4 * q]; a1 = om0[4 * q + 1]; a2 = om0[4 * q + 2]; a3 = om0[4 * q + 3]; }
                    const float pm = (a0 * a1) * (a2 * a3), pp = xhalf(pm, hi);
                    acc *= hi ? 1.0f : pp;
                    const float s3 = acc, s2 = s3 * a3, s1 = s2 * a2, s0 = s1 * a1;
                    if (uu >= 4) { p1[4 * q] *= s0; p1[4 * q + 1] *= s1; p1[4 * q + 2] *= s2; p1[4 * q + 3] *= s3; } else { p0[4 * q] *= s0; p0[4 * q + 1] *= s1; p0[4 * q + 2] *= s2; p0[4 * q + 3] *= s3; }
                    acc *= pm; acc *= hi ? pp : 1.0f; }
                carry = acc;
                bf16x8 pa0, pa1, pa2, pa3;
                pack_p(p0, p1, pa0, pa1, pa2, pa3);
                pv_tile(o, vb0 + buf * SHM_V, pa0, pa1, pa2, pa3);
            }
            if (lane == 0) DONE[(it & 1) * 8 + w] = __all(carry < SB_EPS) ? 1u : 0u;
            if (more) stage_write<true>(st, lds + (buf ^ 1) * SHM_K, lds + 2 * SHM_K + (buf ^ 1) * SHM_V, sr, sc);
            __syncthreads();
            if (!more) break;
            unsigned alld = 1u;
#pragma unroll
            for (int ww = 0; ww < 8; ++ww) alld &= DONE[(it & 1) * 8 + ww];
            if (alld) break;
            --j; buf ^= 1; ++it;
        }
        __syncthreads();
        { LAS char* ost = lds + 73728 + w * 8192;
#pragma unroll
          for (int r = 0; r < 16; ++r) { LAS char* op = ost + crow(r, hi) * 256 + r32 * 2;
#pragma unroll
              for (int d0 = 0; d0 < 4; ++d0) { const float v = o[d0][r], vn = lx1(v); if ((r32 & 1) == 0) *(LAS unsigned*)(op + d0 * 64) = cvtpk(v, vn); } }
          bf16* ob = O + ((size_t)b * S_ + rlo + (lane >> 4)) * D_ + h * HD + (lane & 15) * 8;
#pragma unroll
          for (int i = 0; i < 8; ++i) { const u32x4 v = *(const LAS u32x4*)(ost + i * 1024 + lane * 16); *(u32x4*)(ob + (size_t)(4 * i) * D_) = v; } }
    }
    __builtin_amdgcn_s_setprio(0);
}


constexpr int NPHASE = 2 + 8 * NLAYER;
#ifndef MK_MULTI
#define MK_MULTI 0
#endif
#ifndef PHMASK
#define PHMASK 0xFFFF
#endif
#define PHSEL(b) ((PHMASK >> (b)) & 1)
#ifndef PROBE_REP
#define PROBE_REP 0
#endif
#define NREP(b) (1 + ((PROBE_REP >> (b)) & 1))
__global__ void __launch_bounds__(NTHR, 2) yoco_fwd(Args args) {
    extern __shared__ __attribute__((aligned(16))) unsigned char lds_raw[];
    Frame F;
    F.lds = (LAS unsigned char*)lds_raw;
    const int wave_s = __builtin_amdgcn_readfirstlane((int)threadIdx.x >> 6);
    F.tid = mk_tid(wave_s); F.lane = F.tid & 63; F.wave = wave_s;
    F.G = gridDim.x; F.vcu = blockIdx.x; F.ws = args.ws;
    unsigned char* ws = args.ws;
    unsigned* ctl = (unsigned*)(ws + WS_CTL);
    volatile LAS unsigned* MISC = (volatile LAS unsigned*)(F.lds + MISC_OFF);
    for (int u = F.tid; u < (LDS_BYTES - LDSCTL_OFF) / 4; u += NTHR) ((LAS unsigned*)(F.lds + LDSCTL_OFF))[u] = 0u;
    __syncthreads();
    const int lo = args.ph_lo, hi = args.ph_hi;
    XcdBarrier bar; bar.bar = ctl + CW_BAR; bar.x = 0; bar.st = nullptr;
    if (hi - lo > 1) bar = xcd_barrier_post(ctl + CW_BAR, MISC + 8, F.tid == 0);
#define IN(k) (lo <= (k) && (k) < hi)
#define SEAM(k) do { if ((k) + 1 < hi) xcd_barrier(bar, mk_tid(wave_s) == 0); } while (0)
#define GSEAM(k) do { if ((k) + 1 < hi) { if (lo == 0) group_barrier(bar, mk_tid(wave_s)); else xcd_barrier(bar, mk_tid(wave_s) == 0); } } while (0)

#define DEF_BUFS \
    const float* MODV = (const float*)(ws + WS_MODV); \
    const float* KVMOD = (const float*)(ws + WS_KVMOD); \
    bf16* Hb = (bf16*)(ws + WS_H); bf16* HKb = (bf16*)(ws + WS_HK); bf16* Qb = (bf16*)(ws + WS_Q); bf16* KV6 = (bf16*)(ws + WS_KV6); \
    float* GATES = (float*)(ws + WS_GATES); bf16* KCMP = (bf16*)(ws + WS_KCMP); bf16* Ob = (bf16*)(ws + WS_O); bf16* Yb = (bf16*)(ws + WS_Y); \
    bf16* ACTb = (bf16*)(ws + WS_ACT); bf16* KSH = (bf16*)(ws + WS_KSH); bf16* VSH = (bf16*)(ws + WS_VSH);
    DEF_BUFS
    const float* NORMG = args.in[I_NORMG];
    bf16* XB = (bf16*)(ws + WS_XB);

#if PHSEL(0)
    if (IN(0)) { for (int rep = 0; rep < NREP(0); ++rep) { p0_prologue(F, args); __syncthreads(); } SEAM(0); }
#endif
#if PHSEL(1)
    if (IN(1)) { norm_phase<false, true>(F, args.in[I_X], nullptr, nullptr, nullptr, nullptr, NORMG + 0, MODV + 0 * D_, MODV + 1 * D_, Hb, nullptr, nullptr, nullptr, nullptr); GSEAM(1); }
#endif

    for (int L = 0; L < NLAYER; ++L) {
        const int pb = 2 + 8 * L;
#define RETID() do { const int t_ = mk_tid(wave_s); F.tid = t_; F.lane = t_ & 63; F.wave = wave_s; } while (0)
        RETID();
        int bx_ = (int)blockIdx.x; asm volatile("" : "+s"(bx_));
        { GAS unsigned char* w_ = (GAS unsigned char*)args.ws; asm volatile("" : "+s"(w_)); ws = (unsigned char*)w_; F.ws = ws; }
        DEF_BUFS
        bf16* XB = (bf16*)(ws + WS_XB);
        const float* modL = MODV + (size_t)L * 4 * 12288;
        if (IN(pb + 0)) {
            RETID();
            if (L < 2) {
#if PHSEL(2)
                pg8::Gemm g{Hb, (const bf16*)(ws + WS_WAIN + L * SZ_WAIN), M_, NPROJ, D_}; pg8::StaticOrder S; S.init(M_, NPROJ, F.G, bx_);
                pg8::EpiNsaProj E{Qb, KV6, (const float*)(ws + WS_ROPE)};
                for (int rep = 0; rep < NREP(2); ++rep) pg8::gemm_phase<pg8::EpiNsaProj, pg8::StaticOrder, true, true>(F.lds, g, S, E, F.tid);
#endif

            } else {
#if PHSEL(3)
                { pg8::Gemm g{Hb, (const bf16*)(ws + WS_WBQ + (L - 2) * SZ_WSQ), M_, D_, D_}; pg8::StaticOrder S; S.init(M_, D_, F.G, bx_);
                  pg8::EpiBf16<0> E{Qb, D_, nullptr, 0, 0, 1.f};
                  for (int rep = 0; rep < NREP(3); ++rep) pg8::gemm_phase<pg8::EpiBf16<0>, pg8::StaticOrder, true, true>(F.lds, g, S, E, F.tid); }
                if (L == 2) {
                  __syncthreads();
                  pg8::Gemm g{HKb, (const bf16*)(ws + WS_WKV), M_, 2 * D_, D_}; pg8::StaticOrder S; S.init(M_, 2 * D_, F.G, bx_);
                  pg8::EpiBf16<0> E{KSH, D_, nullptr, D_, (size_t)(WS_VSH - WS_KSH) / 2, 1.f};
                  for (int rep = 0; rep < NREP(3); ++rep) pg8::gemm_phase<pg8::EpiBf16<0>, pg8::StaticOrder, true, true>(F.lds, g, S, E, F.tid); }
#endif
            }

            SEAM(pb + 0);
        }
        if (L < 2 && IN(pb + 1)) {
            RETID();
#if PHSEL(4)
            gate_phase(F, Hb, (const bf16*)(ws + WS_WG + L * SZ_WG), args.in[I_AGATEB] + L * 48, GATES);
            for (int rep = 0; rep < NREP(4); ++rep) compress_phase(F, KV6, (const bf16*)(ws + WS_WC1 + (size_t)(2 * L) * SZ_WC1), (const bf16*)(ws + WS_WC2 + (size_t)(2 * L) * SZ_WC2), (const float*)(ws + WS_PEB) + L * 512, KCMP);
#endif

            SEAM(pb + 1);
        }
        if (IN(pb + 2)) {
            RETID();
            if (L < 2) {
#if PHSEL(5)
                for (int rep = 0; rep < NREP(5); ++rep) nsa_attn_phase(F, Qb, KV6, KCMP, GATES, Ob, (float*)(ws + WS_STASH));
#endif
            } else {
#if PHSEL(6)
                for (int rep = 0; rep < NREP(6); ++rep) sb_attn_phase(F, Qb, KSH, VSH, Ob);
#endif
            }
            SEAM(pb + 2);
        }
        if (IN(pb + 3)) {
            RETID();
            const bf16* wo = (L < 2) ? (const bf16*)(ws + WS_WAOUT + L * SZ_WSQ) : (const bf16*)(ws + WS_WBOUT + (L - 2) * SZ_WSQ);
#if PHSEL(7)
            pg8::Gemm g{Ob, wo, M_, D_, D_}; pg8::StaticOrder S; S.init(M_, D_, F.G, bx_);
            pg8::EpiBf16<0> E{Yb, D_, nullptr, 0, 0, 1.f};
            for (int rep = 0; rep < NREP(7); ++rep) pg8::gemm_phase<pg8::EpiBf16<0>, pg8::StaticOrder, true, true>(F.lds, g, S, E, F.tid);
#endif

            GSEAM(pb + 3);
        }
        if (IN(pb + 4)) {
            RETID();
#if PHSEL(1)
            if (L == 0) norm_phase<false, true>(F, args.in[I_X], Yb, modL + 2 * D_, NORMG + (size_t)(L * 4 + 1) * D_, XB, NORMG + (size_t)(L * 4 + 2) * D_, modL + 3 * D_, modL + 4 * D_, Hb, nullptr, nullptr, nullptr, nullptr);
            else norm_phase<true, true>(F, XB, Yb, modL + 2 * D_, NORMG + (size_t)(L * 4 + 1) * D_, XB, NORMG + (size_t)(L * 4 + 2) * D_, modL + 3 * D_, modL + 4 * D_, Hb, nullptr, nullptr, nullptr, nullptr);
#endif

            GSEAM(pb + 4);
        }
        if (IN(pb + 5)) {
            RETID();
#if PHSEL(8)
            pg8::Gemm g{Hb, (const bf16*)(ws + WS_WFIN + L * SZ_WFIN), M_, 2 * DFF, D_}; pg8::StaticOrder S; S.init(M_, 2 * DFF, F.G, bx_);
            pg8::EpiSwiglu E{ACTb, DFF};
            for (int rep = 0; rep < NREP(8); ++rep) pg8::gemm_phase<pg8::EpiSwiglu, pg8::StaticOrder, true, true>(F.lds, g, S, E, F.tid);
#endif

            GSEAM(pb + 5);
        }
        if (IN(pb + 6)) {
            RETID();
#if PHSEL(9)
            pg8::Gemm g{ACTb, (const bf16*)(ws + WS_WFOUT + L * SZ_WFOUT), M_, D_, DFF}; pg8::StaticOrder S; S.init(M_, D_, F.G, bx_);
            pg8::EpiBf16<0> E{Yb, D_, nullptr, 0, 0, 1.f};
            for (int rep = 0; rep < NREP(9); ++rep) pg8::gemm_phase<pg8::EpiBf16<0>, pg8::StaticOrder, true, true>(F.lds, g, S, E, F.tid);
#endif

            GSEAM(pb + 6);
        }
        if (IN(pb + 7)) {
            RETID();
            const float* modN = MODV + (size_t)(L + 1) * 4 * 12288;
            const bool nx = L + 1 < NLAYER, kv = (L == 1);
#if PHSEL(1)
            if (nx) norm_phase<true, true>(F, XB, Yb, modL + 5 * D_, NORMG + (size_t)(L * 4 + 3) * D_, XB,
                       NORMG + (size_t)((L + 1) * 4 + 0) * D_, modN + 0 * D_, modN + 1 * D_, Hb,
                       kv ? args.in[I_KVNG] : nullptr, kv ? KVMOD : nullptr, kv ? KVMOD + D_ : nullptr, kv ? HKb : nullptr);
            else norm_phase<true, false>(F, XB, Yb, modL + 5 * D_, NORMG + (size_t)(L * 4 + 3) * D_, args.out, nullptr, nullptr, nullptr, nullptr, nullptr, nullptr, nullptr, nullptr);
#endif

            GSEAM(pb + 7);
        }
    }
#undef IN
#undef SEAM
#undef GSEAM
}


#ifndef DBG_TAP
#define DBG_TAP 0
#endif
#if DBG_TAP
__global__ void dbg_tap(Args a, int tap) {
    unsigned char* ws = a.ws; const size_t n = (size_t)M_ * D_;
    const bf16* Hb = (const bf16*)(ws + WS_H); const bf16* Qb = (const bf16*)(ws + WS_Q); const bf16* KV6 = (const bf16*)(ws + WS_KV6); const bf16* Ob = (const bf16*)(ws + WS_O);
    const float* GATES = (const float*)(ws + WS_GATES); const bf16* KCMP = (const bf16*)(ws + WS_KCMP); const float* MODV = (const float*)(ws + WS_MODV);
    const bf16* WFIN = (const bf16*)(ws + WS_WFIN); const bf16* WAIN = (const bf16*)(ws + WS_WAIN); const float* ROPE = (const float*)(ws + WS_ROPE); const float* Yb = (const float*)(ws + WS_Y);
    const bf16* ACTb = (const bf16*)(ws + WS_ACT); const bf16* KSH = (const bf16*)(ws + WS_KSH); const bf16* VSH = (const bf16*)(ws + WS_VSH);
    for (size_t i = (size_t)blockIdx.x * blockDim.x + threadIdx.x; i < n; i += (size_t)gridDim.x * blockDim.x) {
        float v = 0.f;
        if (tap & 1) v += MODV[i % (16 * 12288 + 4 * 4096 + 1024)] + bf2f(WFIN[i]) + bf2f(WAIN[i % ((size_t)NINP * D_)]) + ROPE[i % (S_ * 128)];
        if (tap & 2) v += bf2f(Hb[i]);
        if (tap & 4) v += bf2f(Qb[i]) + bf2f(KV6[i % ((size_t)6 * M_ * 512)]) + bf2f(KV6[(i + (size_t)3 * M_ * 512) % ((size_t)6 * M_ * 512)]) + GATES[i % ((size_t)M_ * 48)];
        if (tap & 8) v += bf2f(KCMP[i % ((size_t)2 * 16 * NCP * HD)]);
        if (tap & 512) { const bf16* W = (const bf16*)(ws + WS_WC1); v += bf2f(W[i % ((size_t)4 * 256 * 4096 + 4 * 128 * 256)]); }
        if (tap & 1024) { const bf16* W = (const bf16*)(ws + WS_WAOUT); v += bf2f(W[i]) + bf2f(W[i + n]) + bf2f(W[(i + 2 * n) % ((WS_WC1 - WS_WAOUT) / 2)]) + bf2f(W[(i + 3 * n) % ((WS_WC1 - WS_WAOUT) / 2)]) + bf2f(W[(i + 4 * n) % ((WS_WC1 - WS_WAOUT) / 2)]) + bf2f(W[(i + 5 * n) % ((WS_WC1 - WS_WAOUT) / 2)]); }
        if (tap & 2048) v += ((const float*)(ws + WS_ACT))[i % ((size_t)256 * 32 * 256)];
        if (tap & 16) v += bf2f(Ob[i]);
        if (tap & 32) v += Yb[i];
        if (tap & 64) v += a.out[i];
        if (tap & 128) v += bf2f(ACTb[i]) + bf2f(ACTb[i + n]);
        if (tap & 256) v += bf2f(KSH[i]) + bf2f(VSH[i]);
        if (tap & 4096) v = (v != v) ? 5000.f : ((fabsf(v) > 100.f) ? 3000.f : v);
        a.out[i] = v;
    }
}
#endif
extern "C" void kernel_launch(void* const* d_in, const int* in_sizes, int n_in, void* d_out, int out_size, void* d_ws, size_t ws_size, hipStream_t stream) {
    static int grid = 0;
    if (grid == 0) {
        if (n_in != 19 || in_sizes[0] != M_ * D_ || out_size != M_ * D_ || ws_size < WS_END) {
            fprintf(stderr, "kernel_launch: unexpected shapes: n_in %d in0 %d out %d ws %zu (need %zu); nothing launched\n", n_in, n_in > 0 ? in_sizes[0] : -1, out_size, ws_size, (size_t)WS_END); grid = -1; return; }
        int dev = 0, cus = 0, per_cu = 0;
        if (hipGetDevice(&dev) != hipSuccess || hipDeviceGetAttribute(&cus, hipDeviceAttributeMultiprocessorCount, dev) != hipSuccess) { grid = -1; return; }
        if (hipFuncSetAttribute((const void*)yoco_fwd, hipFuncAttributeMaxDynamicSharedMemorySize, LDS_BYTES) != hipSuccess) { fprintf(stderr, "kernel_launch: hipFuncSetAttribute failed\n"); grid = -1; return; }
        if (hipOccupancyMaxActiveBlocksPerMultiprocessor(&per_cu, (const void*)yoco_fwd, NTHR, LDS_BYTES) != hipSuccess || per_cu < 1)
            fprintf(stderr, "kernel_launch: note: occupancy query reports %d workgroups per CU\n", per_cu);
        (void)hipGetLastError();
        grid = cus > 256 ? 256 : cus;
    }
    if (grid < 0) return;
    if (hipMemsetAsync((char*)d_ws + WS_CTL, 0, CTL_ZERO_BYTES, stream) != hipSuccess) return;
    Args a{};
    for (int i = 0; i < 19; ++i) a.in[i] = (const float*)d_in[i];
    a.out = (float*)d_out; a.ws = (unsigned char*)d_ws; a.dbg = 0; a.pad = 0;
    for (int j = 0; j < 64; ++j) a.inv[j] = powf(10000.0f, -(float)j / 64.0f);
#if MK_MULTI
#ifndef DBG_STOP
#define DBG_STOP NPHASE
#endif
    for (int ph = 0; ph < DBG_STOP; ++ph) {
        if (ph >= 2 && ((ph - 2) & 7) == 1 && (ph - 2) / 8 >= 2) continue;
        a.ph_lo = ph; a.ph_hi = ph + 1;
        hipLaunchKernelGGL(yoco_fwd, dim3(grid), dim3(NTHR), LDS_BYTES, stream, a);
    }
#if DBG_TAP
    hipLaunchKernelGGL(dbg_tap, dim3(2048), dim3(256), 0, stream, a, (int)DBG_TAP);
#endif
#else
    a.ph_lo = 0; a.ph_hi = NPHASE;
    hipLaunchKernelGGL(yoco_fwd, dim3(grid), dim3(NTHR), LDS_BYTES, stream, a);
#endif
}
```

```cpp
#include <hip/hip_runtime.h>
#include <cstdio>
#include <cstdint>
#include <type_traits>
namespace pg8 {
#define PG8_LAS __attribute__((address_space(3)))
typedef unsigned short bf16_t;
typedef short bf16x8 __attribute__((ext_vector_type(8)));
typedef float f32x4 __attribute__((ext_vector_type(4)));
typedef unsigned u32x4 __attribute__((ext_vector_type(4)));
constexpr int BM = 256, BK = 64, HALF = 128, HTB = HALF * BK * 2  , STAGE_BYTES = 8 * HTB, NXCD = 8, WGM = 8;

__host__ __device__ __forceinline__ int lds_byte(int r, int c) { const int st = (r >> 4) * 2 + (c >> 5), rr = r & 15, cc = c & 31, ob = rr * 64 + cc * 2; return st * 1024 + (ob ^ (((ob >> 9) & 1) << 5)); }
__host__ __device__ __forceinline__ void stage_rc(int b, int& R, int& C) { const int st = b / 1024, sb = b % 1024, swz = sb ^ (((sb >> 9) & 1) << 5); R = (st >> 1) * 16 + swz / 64; C = (st & 1) * 32 + (swz % 64) / 2; }
__host__ __device__ __forceinline__ int perm32(int rho) { const int n = rho >> 4, i = rho & 15; return 8 * (i >> 2) + 4 * n + (i & 3); }

struct Unit { int pm, pn; };
struct Gemm { const bf16_t* A; const bf16_t* Bt; int M, N, K; };

struct StaticOrder {
    int nM, nN, nwg, G, c;
    __host__ __device__ void init(int M, int N, int G_, int c_) { nM = M / BM; nN = N / BM; nwg = nM * nN; G = G_; c = c_; }
    __host__ __device__ bool next(int i, Unit& u) const {
        const long L = (long)i * G + c; if (L >= nwg) return false;
        int wgid = (int)L; { const int q = nwg / NXCD, r = nwg % NXCD, xcd = wgid % NXCD, off = wgid / NXCD; wgid = (xcd < r ? xcd * (q + 1) : r * (q + 1) + (xcd - r) * q) + off; }
        const int nig = WGM * nN, gid = wgid / nig, fm = gid * WGM, gsz = (nM - fm) < WGM ? (nM - fm) : WGM;
        u.pm = fm + ((wgid % nig) % gsz); u.pn = (wgid % nig) / gsz; return true;
    }
    __device__ __forceinline__ void a_ready(const Unit&) const {}
    __device__ __forceinline__ void done(const Unit&) const {}
};
typedef __bf16 bf16x2_t __attribute__((ext_vector_type(2)));
typedef float f32x2_t __attribute__((ext_vector_type(2)));
__device__ __forceinline__ unsigned cvt_pk_bf16(float lo, float hi) { f32x2_t v = {lo, hi}; bf16x2_t b = __builtin_convertvector(v, bf16x2_t); return __builtin_bit_cast(unsigned, b); }
typedef float f32x2 __attribute__((ext_vector_type(2)));
__device__ __forceinline__ f32x2 gelu_pk(f32x2 v) {
    const f32x2 av = __builtin_elementwise_abs(v), d = av * 0.2316418882f + 1.0f;
    f32x2 t; t.x = __builtin_amdgcn_rcpf(d.x); t.y = __builtin_amdgcn_rcpf(d.y);
    f32x2 q = t * 0.5307027145f + (-0.7265760135f); q = q * t + 0.7107068705f; q = q * t + (-0.142248368f); q = q * t + 0.127414796f; q = q * t;
    const f32x2 s = (v * v) * (-0.72134752044f);
    f32x2 e; e.x = __builtin_amdgcn_exp2f(s.x); e.y = __builtin_amdgcn_exp2f(s.y);
    const f32x2 m = v * (q * e), r = v - m;
    f32x2 o; o.x = v.x < 0.f ? m.x : r.x; o.y = v.y < 0.f ? m.y : r.y; return o;
}

template <int ACT  > struct EpiBf16 {
    static constexpr bool PERM = true, AFTER_DRAIN = false; static_assert(ACT == 0 || ACT == 1, "EpiBf16: ACT is 0 (none) or 1 (gelu_pk)");
    static constexpr int S_MIN = 16;
    bf16_t* O; int ldc; const float* bias; int split_cols; size_t split_stride; float scale0;
    __device__ __forceinline__ void operator()(const f32x4 (&acc)[2][2][4][2], const Unit& u, int wr, int wc, int fr, int fq) const {
        const int row0 = u.pm * BM + wr * 64 + fr; int colt = u.pn * BM; bf16_t* base = O;
        float sc = 1.f; if (split_cols) { const int t = colt / split_cols; base += (size_t)t * split_stride; colt -= t * split_cols; if (t == 0) sc = scale0; }
        const int col0 = colt + wc * 32 + 8 * fq, bcol0 = u.pn * BM + wc * 32 + 8 * fq;
        f32x4 bv[2][2];
#pragma unroll
        for (int bj = 0; bj < 2; ++bj)
#pragma unroll
            for (int n = 0; n < 2; ++n) bv[bj][n] = bias ? *(const f32x4*)(bias + bcol0 + bj * HALF + 4 * n) : (f32x4){0.f, 0.f, 0.f, 0.f};
#pragma unroll
        for (int ai = 0; ai < 2; ++ai)
#pragma unroll
            for (int m = 0; m < 4; ++m) { bf16_t* rowp = base + (size_t)(row0 + ai * HALF + m * 16) * ldc + col0;
#pragma unroll
                for (int bj = 0; bj < 2; ++bj) { f32x4 v0 = acc[ai][bj][m][0] + bv[bj][0], v1 = acc[ai][bj][m][1] + bv[bj][1];
                    if (ACT == 1) { f32x2 a = gelu_pk((f32x2){v0[0], v0[1]}), b = gelu_pk((f32x2){v0[2], v0[3]}), c = gelu_pk((f32x2){v1[0], v1[1]}), d = gelu_pk((f32x2){v1[2], v1[3]});
                        v0 = (f32x4){a.x, a.y, b.x, b.y}; v1 = (f32x4){c.x, c.y, d.x, d.y}; }
                    v0 = v0 * sc; v1 = v1 * sc; u32x4 w; w.x = cvt_pk_bf16(v0[0], v0[1]); w.y = cvt_pk_bf16(v0[2], v0[3]); w.z = cvt_pk_bf16(v1[0], v1[1]); w.w = cvt_pk_bf16(v1[2], v1[3]);
                    *(u32x4*)(rowp + bj * HALF) = w; } }
    }
};
struct EpiF32 {
    static constexpr bool PERM = false, AFTER_DRAIN = false;
    static constexpr int S_MIN = 16;
    float* C; int ldc;
    __device__ __forceinline__ void operator()(const f32x4 (&acc)[2][2][4][2], const Unit& u, int wr, int wc, int fr, int fq) const {
        const int row0 = u.pm * BM + wr * 64 + fr, col0 = u.pn * BM + wc * 32 + 4 * fq;
#pragma unroll
        for (int ai = 0; ai < 2; ++ai)
#pragma unroll
            for (int m = 0; m < 4; ++m) { float* rowp = C + (size_t)(row0 + ai * HALF + m * 16) * ldc + col0;
#pragma unroll
                for (int bj = 0; bj < 2; ++bj)
#pragma unroll
                    for (int n = 0; n < 2; ++n) *(f32x4*)(rowp + bj * HALF + n * 16) = acc[ai][bj][m][n]; }
    }
};
typedef unsigned u32x2 __attribute__((ext_vector_type(2)));
struct EpiNsaProj {
    static constexpr bool PERM = true, AFTER_DRAIN = false;
    static constexpr int S_MIN = 16;
    bf16_t* Q; bf16_t* KV6; const float* rope;
    __device__ __forceinline__ void operator()(const f32x4 (&acc)[2][2][4][2], const Unit& u, int wr, int wc, int fr, int fq) const {
        const int row0 = u.pm * BM + wr * 64 + fr, j = wc * 4 + fq;
        const int seg0 = u.pn * 2;
        bf16_t* dst; int ld; bool do_rope;
        if (seg0 < 16) { dst = Q + seg0 * 128; ld = 2048; do_rope = true; }
        else { const int s6 = (seg0 - 16) >> 2, gg = (seg0 - 16) & 3; dst = KV6 + (size_t)s6 * ((size_t)16384 * 512) + gg * 128; ld = 512; do_rope = (s6 == 0) || (s6 == 2) || (s6 == 4); }
#pragma unroll
        for (int ai = 0; ai < 2; ++ai)
#pragma unroll
            for (int mp = 0; mp < 2; ++mp) {
                f32x4 cs[2], sn[2];
                if (do_rope) {
#pragma unroll
                    for (int e = 0; e < 2; ++e) { const int row = row0 + ai * HALF + (2 * mp + e) * 16; const float* rp = rope + ((size_t)(row & 4095) * 64 + 4 * j) * 2;
                        const f32x4 c01 = *(const f32x4*)rp, c23 = *(const f32x4*)(rp + 4);
                        cs[e] = (f32x4){c01[0], c01[2], c23[0], c23[2]}; sn[e] = (f32x4){c01[1], c01[3], c23[1], c23[3]}; }
                }
#pragma unroll
                for (int bj = 0; bj < 2; ++bj) {
                    u32x2 w1[2], w2[2];
#pragma unroll
                    for (int e = 0; e < 2; ++e) { const int m = 2 * mp + e;
                        f32x4 x1 = acc[ai][bj][m][0], x2 = acc[ai][bj][m][1];
                        if (do_rope) { const f32x4 o1 = x1 * cs[e] - x2 * sn[e], o2 = x2 * cs[e] + x1 * sn[e]; x1 = o1; x2 = o2; }
                        w1[e].x = cvt_pk_bf16(x1[0], x1[1]); w1[e].y = cvt_pk_bf16(x1[2], x1[3]); w2[e].x = cvt_pk_bf16(x2[0], x2[1]); w2[e].y = cvt_pk_bf16(x2[2], x2[3]); }
                    const auto ax = __builtin_amdgcn_permlane16_swap(w1[0].x, w1[1].x, false, false), ay = __builtin_amdgcn_permlane16_swap(w1[0].y, w1[1].y, false, false);
                    const auto bx = __builtin_amdgcn_permlane16_swap(w2[0].x, w2[1].x, false, false), by = __builtin_amdgcn_permlane16_swap(w2[0].y, w2[1].y, false, false);
                    u32x4 o1, o2; o1.x = ax[0]; o1.y = ay[0]; o1.z = ax[1]; o1.w = ay[1]; o2.x = bx[0]; o2.y = by[0]; o2.z = bx[1]; o2.w = by[1];
                    bf16_t* rp2 = dst + bj * 128 + (size_t)(row0 + ai * HALF + (2 * mp + (fq & 1)) * 16) * ld + 4 * (j & ~1);
                    *(u32x4*)rp2 = o1; *(u32x4*)(rp2 + 64) = o2; }
            }
    }
};
struct EpiSwiglu {
    static constexpr bool PERM = true, AFTER_DRAIN = false;
    static constexpr int S_MIN = 8;
    bf16_t* O; int ldc;
    __device__ __forceinline__ u32x2 act4(const f32x4& g, const f32x4& up) const { f32x4 r;
#pragma unroll
        for (int i = 0; i < 4; ++i) r[i] = g[i] * __builtin_amdgcn_rcpf(1.0f + __builtin_amdgcn_exp2f(-1.4426950408889634f * g[i])) * up[i];
        u32x2 w; w.x = cvt_pk_bf16(r[0], r[1]); w.y = cvt_pk_bf16(r[2], r[3]); return w; }
    __device__ __forceinline__ void operator()(const f32x4 (&acc)[2][2][4][2], const Unit& u, int wr, int wc, int fr, int fq) const {
        const int row0 = u.pm * BM + wr * 64 + fr + (fq & 1) * 16, col0 = (u.pn * BM + wc * 32 + 8 * (fq & ~1)) >> 1;
#pragma unroll
        for (int ai = 0; ai < 2; ++ai)
#pragma unroll
            for (int mp = 0; mp < 2; ++mp) { bf16_t* rowp = O + (size_t)(row0 + ai * HALF + mp * 32) * ldc + col0;
#pragma unroll
                for (int bj = 0; bj < 2; ++bj) { const u32x2 wa = act4(acc[ai][bj][2 * mp][0], acc[ai][bj][2 * mp][1]), wb = act4(acc[ai][bj][2 * mp + 1][0], acc[ai][bj][2 * mp + 1][1]);
                    const auto sx = __builtin_amdgcn_permlane16_swap(wa.x, wb.x, false, false), sy = __builtin_amdgcn_permlane16_swap(wa.y, wb.y, false, false);
                    u32x4 w; w.x = sx[0]; w.y = sy[0]; w.z = sx[1]; w.w = sy[1];
                    *(u32x4*)(rowp + bj * (HALF / 2)) = w; } }
    }
};
template <class Epi, class Sched, bool ALIGN_EPI = false, bool SP2 = false>
__device__ __forceinline__ void gemm_phase(PG8_LAS unsigned char* lds, const Gemm g, const Sched& S, const Epi& E, int tid_in) {
    int tid_ = tid_in; asm volatile("" : "+v"(tid_));
    const int tid = tid_, wid = __builtin_amdgcn_readfirstlane(tid >> 6), lane = tid & 63, wr = wid >> 2, wc = wid & 3, fr = lane & 15, fq = lane >> 4;
    const int K = g.K, nt = K / BK;
    unsigned voffA[2], voffB[2];
#pragma unroll
    for (int i = 0; i < 2; ++i) { int R, C; stage_rc(tid * 16 + i * 8192, R, C); const int Rb = Epi::PERM ? ((R & ~31) + perm32(R & 31)) : R;
        voffA[i] = (unsigned)(R * K + C) * 2u; voffB[i] = (unsigned)(Rb * K + C) * 2u; }
    const size_t kstep = (size_t)(BK * 2);
    const size_t hstep = (size_t)HALF * K * 2;
    const size_t tstep = 2 * hstep;
    const unsigned ldsw = (unsigned)wid * 1024u;
    const int aoff = lds_byte(wr * 64 + fr, fq * 8), boff = lds_byte(wc * 32 + fr, fq * 8);
#define PG8_SA(b, h) (((b) * 2 + (h)) * HTB)
#define PG8_SB(b, h) ((4 + (b) * 2 + (h)) * HTB)
#define PG8_STAGE(bufoff, gbase, voff) do { _Pragma("unroll") for (int _i = 0; _i < 2; ++_i) \
        __builtin_amdgcn_global_load_lds((const unsigned*)((const char*)(gbase) + (voff)[_i]), (PG8_LAS unsigned*)(lds + (bufoff) + ldsw + _i * 8192), 16, 0, 0); } while (0)
#define PG8_LDA(dst, b, h) do { _Pragma("unroll") for (int m = 0; m < 4; ++m) _Pragma("unroll") for (int k = 0; k < 2; ++k) dst[m][k] = *(const PG8_LAS bf16x8*)(lds + PG8_SA(b, h) + aoff + m * 2048 + k * 1024); } while (0)
#define PG8_LDB(dst, b, h) do { _Pragma("unroll") for (int n = 0; n < 2; ++n) _Pragma("unroll") for (int k = 0; k < 2; ++k) dst[n][k] = *(const PG8_LAS bf16x8*)(lds + PG8_SB(b, h) + boff + n * 2048 + k * 1024); } while (0)
#define PG8_MMA(ai, bj, At, Bt) do { __builtin_amdgcn_s_setprio(1); _Pragma("unroll") for (int m = 0; m < 4; ++m) _Pragma("unroll") for (int n = 0; n < 2; ++n) _Pragma("unroll") for (int k = 0; k < 2; ++k) \
        acc[ai][bj][m][n] = __builtin_amdgcn_mfma_f32_16x16x32_bf16(Bt[n][k], At[m][k], acc[ai][bj][m][n], 0, 0, 0); __builtin_amdgcn_s_setprio(0); } while (0)
#define PG8_WAIT_V(n) asm volatile("s_waitcnt vmcnt(" #n ")" ::: "memory")
#define PG8_WAIT_L(n) asm volatile("s_waitcnt lgkmcnt(" #n ")" ::: "memory")
#define PG8_BAR __builtin_amdgcn_s_barrier()
#define PG8_SCHED __builtin_amdgcn_sched_barrier(0)
    static_assert(ALIGN_EPI && SP2, "this copy keeps only the two-super-phase loop with aligned epilogues");
    Unit cur, nxt; int ui = 0;
    if (!S.next(0, cur)) return;
    f32x4 acc[2][2][4][2];
#pragma unroll
    for (int a = 0; a < 2; ++a)
#pragma unroll
        for (int b = 0; b < 2; ++b)
#pragma unroll
            for (int m = 0; m < 4; ++m)
#pragma unroll
                for (int n = 0; n < 2; ++n) { acc[a][b][m][n] = (f32x4){0.f, 0.f, 0.f, 0.f}; asm volatile("" : "+v"(acc[a][b][m][n])); }
    bf16x8 At[4][2], B0[2][2], B1[2][2];
    const char* cA = (const char*)g.A + (size_t)cur.pm * tstep; const char* cB = (const char*)g.Bt + (size_t)cur.pn * tstep;
    const char* nA = cA; const char* nB = cB; bool has_next = false;
    S.a_ready(cur);
    PG8_STAGE(PG8_SB(0, 0), cB, voffB); PG8_STAGE(PG8_SB(0, 1), cB + hstep, voffB); PG8_STAGE(PG8_SA(0, 0), cA, voffA); PG8_STAGE(PG8_SA(0, 1), cA + hstep, voffA);
    PG8_STAGE(PG8_SB(1, 0), cB + kstep, voffB); PG8_STAGE(PG8_SA(1, 0), cA + kstep, voffA); PG8_STAGE(PG8_SB(1, 1), cB + hstep + kstep, voffB); PG8_STAGE(PG8_SA(1, 1), cA + hstep + kstep, voffA);
    if (wr == 1) PG8_BAR;
    PG8_WAIT_V(0); PG8_BAR; PG8_BAR;
    constexpr int W0 = 10 + Epi::S_MIN;
    auto ktiles = [&](const int t, const int nt_, const int first) __attribute__((always_inline)) {
        const bool last = (t == nt_ - 2);
        const char* a1 = cA + (size_t)(t + 1) * kstep;
        const char* a2 = last ? nA : cA + (size_t)(t + 2) * kstep; const char* b2 = last ? nB : cB + (size_t)(t + 2) * kstep;
        const char* a3 = a2 + kstep; const char* b3 = b2 + kstep;
        if (last && has_next) S.a_ready(nxt);
        PG8_LDB(B0, 0, 0); PG8_LDB(B1, 0, 1); PG8_SCHED; PG8_LDA(At, 0, 0); PG8_STAGE(PG8_SA(1, 1), a1 + hstep, voffA);
        if (first) asm volatile("s_waitcnt vmcnt(%0)" :: "n"(W0) : "memory"); else PG8_WAIT_V(8); PG8_WAIT_L(0); PG8_BAR; PG8_MMA(0, 0, At, B0); PG8_MMA(0, 1, At, B1); PG8_BAR; PG8_SCHED;
        PG8_LDA(At, 0, 1); PG8_STAGE(PG8_SB(0, 0), b2, voffB); PG8_STAGE(PG8_SB(0, 1), b2 + hstep, voffB); PG8_STAGE(PG8_SA(0, 0), a2, voffA);
        if (first) asm volatile("s_waitcnt vmcnt(%0)" :: "n"(W0) : "memory"); else PG8_WAIT_V(8); PG8_WAIT_L(0); PG8_BAR; PG8_MMA(1, 0, At, B0); PG8_MMA(1, 1, At, B1); PG8_BAR; PG8_SCHED;
        PG8_LDB(B0, 1, 0); PG8_LDB(B1, 1, 1); PG8_SCHED; PG8_LDA(At, 1, 0); PG8_STAGE(PG8_SA(0, 1), a2 + hstep, voffA);
        if (first) asm volatile("s_waitcnt vmcnt(%0)" :: "n"(W0) : "memory"); else PG8_WAIT_V(8); PG8_WAIT_L(0); PG8_BAR; PG8_MMA(0, 0, At, B0); PG8_MMA(0, 1, At, B1); PG8_BAR; PG8_SCHED;
        PG8_LDA(At, 1, 1); PG8_STAGE(PG8_SB(1, 0), b3, voffB); PG8_STAGE(PG8_SB(1, 1), b3 + hstep, voffB); PG8_STAGE(PG8_SA(1, 0), a3, voffA);
        PG8_WAIT_V(8); PG8_WAIT_L(0); PG8_BAR; PG8_MMA(1, 0, At, B0); PG8_MMA(1, 1, At, B1); PG8_BAR; PG8_SCHED;
    };
    for (;;) {
        has_next = S.next(ui + 1, nxt);
        nA = has_next ? (const char*)g.A + (size_t)nxt.pm * tstep : cA; nB = has_next ? (const char*)g.Bt + (size_t)nxt.pn * tstep : cB;
        int sm = 1; asm volatile("" : "+s"(sm));
#pragma nounroll
        for (int t = 0; t < nt; t += 2) { ktiles(t, nt, sm); sm = 0; asm volatile("" : "+s"(sm)); }
        if (wr == 0) PG8_BAR;
        if (has_next) PG8_STAGE(PG8_SA(1, 1), nA + kstep + hstep, voffA);
        if constexpr (!Epi::AFTER_DRAIN) { E(acc, cur, wr, wc, fr, fq); S.done(cur); }
        if (!has_next) break;
#pragma unroll
        for (int a = 0; a < 2; ++a)
#pragma unroll
            for (int b = 0; b < 2; ++b)
#pragma unroll
                for (int m = 0; m < 4; ++m)
#pragma unroll
                    for (int n = 0; n < 2; ++n) { acc[a][b][m][n] = (f32x4){0.f, 0.f, 0.f, 0.f}; asm volatile("" : "+v"(acc[a][b][m][n])); }
        cur = nxt; cA = nA; cB = nB; ++ui;
        if (wr == 1) PG8_BAR;
    }
    PG8_WAIT_V(0);
    PG8_BAR;
    if constexpr (Epi::AFTER_DRAIN) { E.fused(acc, cur, wr, wc, fr, fq, lds, wid, lane); S.done(cur); }
#undef PG8_SA
#undef PG8_SB
#undef PG8_STAGE
#undef PG8_LDA
#undef PG8_LDB
#undef PG8_MMA
#undef PG8_WAIT_V
#undef PG8_WAIT_L
#undef PG8_BAR
#undef PG8_SCHED
}
}

constexpr int NB_ = 4, S_ = 4096, D_ = 2048, M_ = NB_ * S_, NH = 16, HD = 128, NG = 4, DFF = 5632, NIN = 5168, NINP = 5376, NPROJ = 5120  , NLAYER = 4;
constexpr int NCP = 256;
constexpr float EPS = 1e-6f;
constexpr float SCALE = 0.08838834764831845f;
constexpr float C2 = SCALE * 1.4426950408889634f;
constexpr int NWAVES = 8, NTHR = 512;

constexpr size_t MiB = 1u << 20;
constexpr size_t WS_CTL = 0, CTL_ZERO_BYTES = 1 * MiB;
constexpr size_t WS_MODV = 1 * MiB;
constexpr size_t WS_KVMOD = WS_MODV + (size_t)4 * 4 * 12288 * 4;
constexpr size_t WS_PEB = WS_KVMOD + (size_t)4 * 4096 * 4;
constexpr size_t WS_ROPE = 2 * MiB;
constexpr size_t WS_WAIN = 4 * MiB;
constexpr size_t SZ_WAIN = (size_t)NINP * D_ * 2;
constexpr size_t WS_WAOUT = WS_WAIN + 2 * SZ_WAIN;
constexpr size_t SZ_WSQ = (size_t)D_ * D_ * 2;
constexpr size_t WS_WBQ = WS_WAOUT + 2 * SZ_WSQ;
constexpr size_t WS_WBOUT = WS_WBQ + 2 * SZ_WSQ;
constexpr size_t WS_WKV = WS_WBOUT + 2 * SZ_WSQ;
constexpr size_t WS_WFIN = WS_WKV + 2 * SZ_WSQ;
constexpr size_t SZ_WFIN = (size_t)2 * DFF * D_ * 2;
constexpr size_t WS_WFOUT = WS_WFIN + 4 * SZ_WFIN;
constexpr size_t SZ_WFOUT = (size_t)D_ * DFF * 2;
constexpr size_t WS_WC1 = WS_WFOUT + 4 * SZ_WFOUT;
constexpr size_t SZ_WC1 = (size_t)256 * 4096 * 2;
constexpr size_t WS_WC2 = WS_WC1 + 4 * SZ_WC1;
constexpr size_t SZ_WC2 = (size_t)128 * 256 * 2;
constexpr size_t WS_WG = WS_WC2 + 4 * SZ_WC2;
constexpr size_t SZ_WG = (size_t)64 * D_ * 2;
constexpr size_t WS_ACT0 = (WS_WG + 2 * SZ_WG + MiB - 1) / MiB * MiB;
constexpr size_t SZ_MD2 = (size_t)M_ * D_ * 2;
constexpr size_t WS_H = WS_ACT0;
constexpr size_t WS_HK = WS_H + SZ_MD2;
constexpr size_t WS_Q = WS_HK + SZ_MD2;
constexpr size_t WS_KV6 = WS_Q + SZ_MD2;
constexpr size_t WS_GATES = WS_KV6 + (size_t)6 * M_ * 512 * 2;
constexpr size_t WS_KCMP = WS_GATES + (size_t)M_ * 48 * 4;
constexpr size_t WS_O = WS_KCMP + (size_t)2 * 16 * NCP * HD * 2;
constexpr size_t WS_Y = WS_O + SZ_MD2;
constexpr size_t WS_ACT = WS_Y + 2 * SZ_MD2;
constexpr size_t WS_KSH = WS_ACT + (size_t)M_ * DFF * 2;
constexpr size_t WS_VSH = WS_KSH + SZ_MD2;
constexpr size_t WS_STASH = WS_VSH + SZ_MD2;
constexpr size_t WS_XB = WS_STASH + (size_t)256 * 32768 * 4;
constexpr size_t WS_END = WS_XB + SZ_MD2;
constexpr int CW_BAR = 4096;
constexpr int CW_DBG = 16384;

constexpr int RING_BYTES = 131072;
constexpr int LDS_BYTES = 147456;
constexpr int LDSCTL_OFF = LDS_BYTES - 1024, MISC_OFF = LDSCTL_OFF + 320;

#define GAS __attribute__((address_space(1)))
#define LAS __attribute__((address_space(3)))
typedef unsigned short bf16;
typedef unsigned u32x4 __attribute__((ext_vector_type(4)));
typedef unsigned u32x2 __attribute__((ext_vector_type(2)));
typedef float f32x4 __attribute__((ext_vector_type(4)));
typedef float f32x2 __attribute__((ext_vector_type(2)));
typedef float f32x16 __attribute__((ext_vector_type(16)));
typedef short bf16x8 __attribute__((ext_vector_type(8)));
typedef short s16x4 __attribute__((ext_vector_type(4)));
#define LDS_WAIT() asm volatile("s_waitcnt lgkmcnt(0)" ::: "memory")
#define VM_WAIT() asm volatile("s_waitcnt vmcnt(0)" ::: "memory")
#define SBAR() __builtin_amdgcn_sched_barrier(0)
__device__ __forceinline__ unsigned cvtpk(float lo, float hi) { return pg8::cvt_pk_bf16(lo, hi); }
__device__ __forceinline__ float bf2f(bf16 v) { return __uint_as_float(((unsigned)v) << 16); }
__device__ __forceinline__ float lx1(float v) { return __int_as_float(__builtin_amdgcn_mov_dpp(__float_as_int(v), 0xB1, 0xF, 0xF, true)); }
__device__ __forceinline__ float lx2(float v) { return __int_as_float(__builtin_amdgcn_mov_dpp(__float_as_int(v), 0x4E, 0xF, 0xF, true)); }
template <int X> __device__ __forceinline__ float lswz(float v) { return __int_as_float(__builtin_amdgcn_ds_swizzle(__float_as_int(v), 0x1F | (X << 10))); }
__device__ __forceinline__ float wave_sum(float v) {
    v += lx1(v); v += lx2(v); v += lswz<4>(v); v += lswz<8>(v); v += lswz<16>(v);
    auto rr = __builtin_amdgcn_permlane32_swap(__float_as_uint(v), __float_as_uint(v), false, false);
    return __uint_as_float(rr[0]) + __uint_as_float(rr[1]);
}

#define XB_TMO      128
#define XB_XCNT(j)  (256  + 64 * (j))
#define XB_XSUB(j)  (1280 + 64 * (j))
#define XB_XGEN(j)  (2304 + 64 * (j))
#define XB_TOP      3328
#define XB_TOPGEN   3392
#define XB_GCNT(j)  (3456 + 64 * (j))
#define XB_XID      4096
#define XCD_BAR_WORDS 3456
#define XB_SPIN_CAP (1u << 18)
__device__ __forceinline__ unsigned xb_ld(unsigned* p)              { return __hip_atomic_load(p, __ATOMIC_RELAXED, __HIP_MEMORY_SCOPE_AGENT); }
__device__ __forceinline__ unsigned xb_add(unsigned* p, unsigned v) { return __hip_atomic_fetch_add(p, v, __ATOMIC_RELAXED, __HIP_MEMORY_SCOPE_AGENT); }
__device__ __forceinline__ unsigned xb_xcc_id() { return (unsigned)__builtin_amdgcn_s_getreg((3 << 11) | 20) & 0xFu; }
#define XB_SPIN(cond, bar) do { unsigned _sp = 0; while (cond) { __builtin_amdgcn_s_sleep(1); \
    if ((++_sp & 255u) == 0u) { if (xb_ld(&(bar)[XB_TMO])) break; if (_sp > XB_SPIN_CAP) { atomicAdd(&(bar)[XB_TMO], 1u); break; } } } } while (0)
struct XcdBarrier { unsigned* bar; unsigned x; volatile LAS unsigned* st; };
__device__ __forceinline__ XcdBarrier xcd_barrier_post(unsigned* bar, volatile LAS unsigned* st, bool leader  ) {
    XcdBarrier b; b.bar = bar; b.x = xb_xcc_id(); b.st = st;
    if (leader) { (void)xb_add(&bar[XB_XCNT(b.x)], 1u); __hip_atomic_store(&bar[XB_XID + blockIdx.x], b.x + 1u, __ATOMIC_RELAXED, __HIP_MEMORY_SCOPE_AGENT); }
    return b;
}
__device__ __forceinline__ void xcd_barrier_complete(unsigned* bar, unsigned x, unsigned& nloc, unsigned& nx) {
    const unsigned G = gridDim.x * gridDim.y * gridDim.z;
    unsigned sum, cnt, mine, sp = 0u;
    for (;;) {
        sum = 0u; cnt = 0u; mine = 0u;
#pragma unroll
        for (unsigned j = 0; j < 16; ++j) { const unsigned c = xb_ld(&bar[XB_XCNT(j)]); sum += c; cnt += (c > 0u) ? 1u : 0u; mine = (j == x) ? c : mine; }
        if (sum == G) break;
        __builtin_amdgcn_s_sleep(1);
        if ((++sp & 255u) == 0u) { if (xb_ld(&bar[XB_TMO])) break; if (sp > XB_SPIN_CAP) { atomicAdd(&bar[XB_TMO], 1u); break; } }
    }
    nloc = mine > 0u ? mine : 1u; nx = cnt > 0u ? cnt : 1u;
}
__device__ __forceinline__ void xcd_barrier(const XcdBarrier& b, bool leader  ) {
    asm volatile("s_waitcnt vmcnt(0)" ::: "memory");
    __syncthreads();
    if (leader) {
        unsigned* bar = b.bar;
        __builtin_amdgcn_s_waitcnt(0);
        unsigned nloc = b.st[0], nx = b.st[1];
        if (nloc == 0u) { xcd_barrier_complete(bar, b.x, nloc, nx); b.st[0] = nloc; b.st[1] = nx; }
        const unsigned old = xb_add(&bar[XB_XSUB(b.x)], 1u);
        const unsigned gen = old / nloc;
        if (old + 1u == (gen + 1u) * nloc) {
            __builtin_amdgcn_fence(__ATOMIC_RELEASE, "agent");
            asm volatile("s_waitcnt vmcnt(0)" ::: "memory");
            const unsigned og = xb_add(&bar[XB_TOP], 1u);
            const unsigned tg = og / nx;
            if (og + 1u == (tg + 1u) * nx) xb_add(&bar[XB_TOPGEN], 1u);
            else XB_SPIN(xb_ld(&bar[XB_TOPGEN]) == tg, bar);
            __builtin_amdgcn_fence(__ATOMIC_ACQUIRE, "agent");
            xb_add(&bar[XB_XGEN(b.x)], 1u);
            asm volatile("s_waitcnt vmcnt(0)" ::: "memory");
        } else {
            XB_SPIN(xb_ld(&bar[XB_XGEN(b.x)]) == gen, bar);
            __builtin_amdgcn_fence(__ATOMIC_ACQUIRE, "agent");
            asm volatile("s_waitcnt vmcnt(0)" ::: "memory");
        }
    }
    __syncthreads();
}

__device__ __forceinline__ void group_barrier(const XcdBarrier& b, int tid) {
    const bool leader = (tid == 0);
    if (b.st[2] == 0u) {
        if (tid < (int)gridDim.x) { const unsigned a = xb_ld(&b.bar[XB_XID + tid]), f = xb_ld(&b.bar[XB_XID + (tid & 7)]); if (a == 0u || a != f) b.st[3] = 1u; }
        if (tid < 8) { const unsigned a = xb_ld(&b.bar[XB_XID + tid]); for (int u = 0; u < tid; ++u) if (xb_ld(&b.bar[XB_XID + u]) == a) b.st[3] = 1u; }
        __syncthreads();
        if (leader) b.st[2] = (gridDim.x == 256u && b.st[3] == 0u) ? 1u : 2u;
        __syncthreads();
    }
    if (b.st[2] != 1u) { xcd_barrier(b, leader); return; }
    asm volatile("s_waitcnt vmcnt(0)" ::: "memory");
    __syncthreads();
    if (leader) {
        unsigned* bar = b.bar; const unsigned g = blockIdx.x & 7u;
        const unsigned old = xb_add(&bar[XB_GCNT(g)], 1u);
        const unsigned target = (old / 32u + 1u) * 32u;
        XB_SPIN(xb_ld(&bar[XB_GCNT(g)]) < target, bar);
        __builtin_amdgcn_fence(__ATOMIC_ACQUIRE, "agent");
        asm volatile("s_waitcnt vmcnt(0)" ::: "memory");
    }
    __syncthreads();
}

__device__ __forceinline__ int mk_tid(int wave_s) { int l; asm volatile("v_mbcnt_lo_u32_b32 %0, -1, 0\n\tv_mbcnt_hi_u32_b32 %0, -1, %0" : "=v"(l)); return (wave_s << 6) | l; }
struct Args { const float* in[19]; float* out; unsigned char* ws; int ph_lo, ph_hi, dbg, pad; float inv[64]; };
enum { I_X = 0, I_C, I_MODW, I_MODB, I_NORMG, I_FWIN, I_FWOUT, I_AWIN, I_AGATEB, I_APE, I_AW1, I_AW2, I_AWOUT, I_BWQ, I_BWOUT, I_KVNG, I_KVMODW, I_KVMODB, I_KVW };
struct Frame {
    LAS unsigned char* lds;
    int tid, lane, wave, vcu, G;
    unsigned char* ws;
};

template <int MODE> __device__ __forceinline__ int src_col(int c) {
    if (MODE == 0) return c;
    if (MODE == 1) { const int g8 = c >> 3, i = c & 7; return (i < 4) ? g8 * 4 + i : DFF + g8 * 4 + (i - 4); }
    if (MODE == 3) return (c < 48) ? 5120 + c : -1;
    if (c >= NIN) return -1;
    if (c >= 5120) return c;
    const int hb = c & ~127, p = c & 127, jj = p >> 3, i = p & 7;
    return hb + ((i < 4) ? 4 * jj + i : 64 + 4 * jj + (i - 4));
}
template <int MODE, int DST = 0> __device__ __forceinline__ void p0_transpose_item(const float* W, int K, int ld, bf16* WT, LAS float* scr, int item, int nblk, int lane) {
    const int kb = item / nblk, nb = item - kb * nblk, k0 = 64 * kb, n0 = 64 * nb;
    const int c4 = (lane & 15) * 4, sc = src_col<MODE>(n0 + c4), kr = lane >> 4;
    f32x4 v[16];
#pragma unroll
    for (int i = 0; i < 16; ++i) v[i] = (sc >= 0) ? *(const f32x4*)(W + (size_t)(k0 + kr + 4 * i) * ld + sc) : (f32x4){0.f, 0.f, 0.f, 0.f};
#pragma unroll
    for (int i = 0; i < 16; ++i) { LAS float* s = scr + (kr + 4 * i) * 65 + c4; s[0] = v[i][0]; s[1] = v[i][1]; s[2] = v[i][2]; s[3] = v[i][3]; }
    LDS_WAIT(); asm volatile("" ::: "memory");
#pragma unroll
    for (int t = 0; t < 8; ++t) { const int q = lane + 64 * t, n = q >> 3, c = q & 7; const LAS float* s = scr + (8 * c) * 65 + n;
        u32x4 o; o.x = cvtpk(s[0], s[65]); o.y = cvtpk(s[2 * 65], s[3 * 65]); o.z = cvtpk(s[4 * 65], s[5 * 65]); o.w = cvtpk(s[6 * 65], s[7 * 65]);
        if (DST == 0) *(u32x4*)(WT + (size_t)(n0 + n) * K + k0 + 8 * c) = o;
        else if (DST == 2) { const int nn = n0 + n, kk = k0 + 8 * c;
            *(u32x4*)(WT + ((size_t)(((nn >> 5) * (K >> 6) + (kk >> 6)) * 4 + ((kk >> 3) & 3)) * 64 + ((kk >> 5) & 1) * 32 + (nn & 31)) * 8) = o; }
        else { const int nn = n0 + n, kk = k0 + 8 * c;
            *(u32x4*)(WT + ((size_t)((nn >> 5) * (K >> 4) + (kk >> 4)) * 64 + ((kk >> 3) & 1) * 32 + (nn & 31)) * 8) = o; } }
    LDS_WAIT(); asm volatile("" ::: "memory");
}
template <int NB, int K> __device__ __forceinline__ void gemv_item(const float* W, int ldw, int col0, const LAS float* xs, LAS float* red, const float* bias, float* out, int ostride, Frame& F) {
    constexpr int kper = K / 8; const int kbeg = F.wave * kper;
    f32x4 acc[NB];
#pragma unroll
    for (int b = 0; b < NB; ++b) acc[b] = (f32x4){0.f, 0.f, 0.f, 0.f};
    const float* wp = W + (size_t)kbeg * ldw + col0 + 4 * F.lane;
    for (int k = 0; k < kper; k += 8) {
        f32x4 w[8];
#pragma unroll
        for (int u = 0; u < 8; ++u) w[u] = *(const f32x4*)(wp + (size_t)(k + u) * ldw);
#pragma unroll
        for (int u = 0; u < 8; ++u)
#pragma unroll
            for (int b = 0; b < NB; ++b) { const float x = xs[b * K + kbeg + k + u]; acc[b] += w[u] * x; }
    }
#pragma unroll
    for (int b = 0; b < NB; ++b) *(LAS f32x4*)(red + ((F.wave * NB + b) * 256 + 4 * F.lane)) = acc[b];
    __syncthreads();
    for (int e = F.tid; e < NB * 256; e += NTHR) { const int b = e >> 8, c = e & 255; float s = 0.f;
#pragma unroll
        for (int w = 0; w < 8; ++w) s += red[(w * NB + b) * 256 + c];
        out[(size_t)b * ostride + col0 + c] = s + (bias ? bias[col0 + c] : 0.f); }
    __syncthreads();
}
__device__ __forceinline__ void sincos_acc(float ang, float& c, float& s) {
    const double x = (double)ang;
    const double k = rint(x * 0.63661977236758134308);
    double r = fma(-k, 1.57079632679489655800, x); r = fma(-k, 6.123233995736766e-17, r);
    const int q = ((int)k) & 3;
    const double r2 = r * r;
    const double sp = r * (1.0 + r2 * (-1.0 / 6 + r2 * (1.0 / 120 + r2 * (-1.0 / 5040 + r2 * (1.0 / 362880 + r2 * (-1.0 / 39916800 + r2 * (1.0 / 6227020800.0)))))));
    const double cp = 1.0 + r2 * (-0.5 + r2 * (1.0 / 24 + r2 * (-1.0 / 720 + r2 * (1.0 / 40320 + r2 * (-1.0 / 3628800 + r2 * (1.0 / 479001600.0 + r2 * (-1.0 / 87178291200.0)))))));
    const double sv = (q == 0) ? sp : (q == 1) ? cp : (q == 2) ? -sp : -cp;
    const double cv = (q == 0) ? cp : (q == 1) ? -sp : (q == 2) ? -cp : sp;
    c = (float)cv; s = (float)sv;
}
__device__ __forceinline__ void p0_prologue(Frame& F, const Args& a) {
    unsigned char* ws = F.ws;
    { float* rope = (float*)(ws + WS_ROPE);
      for (int i = blockIdx.x * NTHR + F.tid; i < S_ * 64; i += F.G * NTHR) { const int s = i >> 6, j = i & 63; float c, sn; sincos_acc((float)s * a.inv[j], c, sn); rope[2 * i] = c; rope[2 * i + 1] = sn; } }
    { LAS float* xs = (LAS float*)F.lds; LAS float* red = (LAS float*)(F.lds + 32768);
      for (int it = blockIdx.x; it < 212; it += F.G) {
          if (it < 208) {
              for (int e = F.tid; e < NB_ * D_; e += NTHR) { const float c = a.in[I_C][e]; xs[e] = c / (1.0f + __expf(-c)); }
              __syncthreads();
              if (it < 192) { const int l = it / 48, ch = it - l * 48;
                  gemv_item<4, D_>(a.in[I_MODW] + (size_t)l * D_ * 12288, 12288, ch * 256, xs, red, a.in[I_MODB] + l * 12288, (float*)(ws + WS_MODV) + (size_t)l * 4 * 12288, 12288, F); }
              else { const int ch = it - 192;
                  gemv_item<4, D_>(a.in[I_KVMODW], 4096, ch * 256, xs, red, a.in[I_KVMODB], (float*)(ws + WS_KVMOD), 4096, F); }
          } else { const int lt = it - 208;
              for (int e = F.tid; e < 4096; e += NTHR) xs[e] = a.in[I_APE][(size_t)lt * 4096 + e];
              __syncthreads();
              gemv_item<1, 4096>(a.in[I_AW1] + (size_t)lt * 4096 * 256, 256, 0, xs, red, nullptr, (float*)(ws + WS_PEB) + lt * 256, 256, F); }
      } }
    __syncthreads();
    { LAS float* scr = (LAS float*)(F.lds + F.wave * 16640);
      const int gw = blockIdx.x * NWAVES + F.wave, NGW = F.G * NWAVES;
      constexpr int C_AIN = 32 * (NPROJ / 64), C_SQ = 32 * 32, C_KV = 32 * 64, C_FIN = 32 * (2 * DFF / 64), C_FOUT = (DFF / 64) * 32, C_W1 = 64 * 4, C_W2 = 4 * 2, C_WG = 32;
      constexpr int NITEMS = 2 * C_AIN + 6 * C_SQ + C_KV + 4 * C_FIN + 4 * C_FOUT + 4 * C_W1 + 4 * C_W2 + 2 * C_WG;
      for (int it = gw; it < NITEMS; it += NGW) {
          int r = it;
          if (r < 4 * C_FIN) { const int l = r / C_FIN; r -= l * C_FIN; p0_transpose_item<1>(a.in[I_FWIN] + (size_t)l * D_ * 2 * DFF, D_, 2 * DFF, (bf16*)(ws + WS_WFIN + l * SZ_WFIN), scr, r, 2 * DFF / 64, F.lane); continue; } r -= 4 * C_FIN;
          if (r < 4 * C_FOUT) { const int l = r / C_FOUT; r -= l * C_FOUT; p0_transpose_item<0>(a.in[I_FWOUT] + (size_t)l * DFF * D_, DFF, D_, (bf16*)(ws + WS_WFOUT + l * SZ_WFOUT), scr, r, D_ / 64, F.lane); continue; } r -= 4 * C_FOUT;
          if (r < 2 * C_AIN) { const int l = r / C_AIN; r -= l * C_AIN; p0_transpose_item<2>(a.in[I_AWIN] + (size_t)l * D_ * NIN, D_, NIN, (bf16*)(ws + WS_WAIN + l * SZ_WAIN), scr, r, NPROJ / 64, F.lane); continue; } r -= 2 * C_AIN;
          if (r < 2 * C_SQ) { const int l = r / C_SQ; r -= l * C_SQ; p0_transpose_item<0>(a.in[I_AWOUT] + (size_t)l * D_ * D_, D_, D_, (bf16*)(ws + WS_WAOUT + l * SZ_WSQ), scr, r, D_ / 64, F.lane); continue; } r -= 2 * C_SQ;
          if (r < 2 * C_SQ) { const int l = r / C_SQ; r -= l * C_SQ; p0_transpose_item<0>(a.in[I_BWQ] + (size_t)l * D_ * D_, D_, D_, (bf16*)(ws + WS_WBQ + l * SZ_WSQ), scr, r, D_ / 64, F.lane); continue; } r -= 2 * C_SQ;
          if (r < 2 * C_SQ) { const int l = r / C_SQ; r -= l * C_SQ; p0_transpose_item<0>(a.in[I_BWOUT] + (size_t)l * D_ * D_, D_, D_, (bf16*)(ws + WS_WBOUT + l * SZ_WSQ), scr, r, D_ / 64, F.lane); continue; } r -= 2 * C_SQ;
          if (r < C_KV) { p0_transpose_item<0>(a.in[I_KVW], D_, 2 * D_, (bf16*)(ws + WS_WKV), scr, r, 2 * D_ / 64, F.lane); continue; } r -= C_KV;
          if (r < 4 * C_W1) { const int l = r / C_W1; r -= l * C_W1; p0_transpose_item<0, 1>(a.in[I_AW1] + (size_t)l * 4096 * 256, 4096, 256, (bf16*)(ws + WS_WC1 + l * SZ_WC1), scr, r, 4, F.lane); continue; } r -= 4 * C_W1;
          if (r < 4 * C_W2) { const int l = r / C_W2; r -= l * C_W2; p0_transpose_item<0>(a.in[I_AW2] + (size_t)l * 256 * 128, 256, 128, (bf16*)(ws + WS_WC2 + l * SZ_WC2), scr, r, 2, F.lane); continue; } r -= 4 * C_W2;
          { const int l = r / C_WG; r -= l * C_WG; p0_transpose_item<3, 2>(a.in[I_AWIN] + (size_t)l * D_ * NIN, D_, NIN, (bf16*)(ws + WS_WG + l * SZ_WG), scr, r, 1, F.lane); }
      } }
}

struct NormRow { f32x4 x[8]; bf16x8 y[4]; };
struct NormArgs { const void* xin; const bf16* y; const float* gate; const float* ng_y; void* xout; const float* ng_h; const float* sh; const float* sc; bf16* h; const float* ng_k; const float* ksh; const float* ksc; bf16* hk; };
__device__ __forceinline__ void bf8_to_f32(const bf16x8& v, f32x4& a, f32x4& b) { const u32x4 w = *reinterpret_cast<const u32x4*>(&v);
    a = (f32x4){__uint_as_float(w.x << 16), __uint_as_float(w.x & 0xffff0000u), __uint_as_float(w.y << 16), __uint_as_float(w.y & 0xffff0000u)};
    b = (f32x4){__uint_as_float(w.z << 16), __uint_as_float(w.z & 0xffff0000u), __uint_as_float(w.w << 16), __uint_as_float(w.w & 0xffff0000u)}; }
template <bool XIN16> __device__ __forceinline__ void norm_load(NormRow& R, const NormArgs& A, int m, int lane) {
    const size_t ro = (size_t)m * D_ + 8 * lane;
    if (XIN16) {
#pragma unroll
        for (int j = 0; j < 4; ++j) { const bf16x8 v = *(const bf16x8*)((const bf16*)A.xin + ro + 512 * j); *reinterpret_cast<bf16x8*>(&R.x[2 * j]) = v; }
    } else {
#pragma unroll
        for (int j = 0; j < 4; ++j) { R.x[2 * j] = *(const f32x4*)((const float*)A.xin + ro + 512 * j); R.x[2 * j + 1] = *(const f32x4*)((const float*)A.xin + ro + 512 * j + 4); }
    }
    if (A.y) {
#pragma unroll
        for (int j = 0; j < 4; ++j) R.y[j] = *(const bf16x8*)(A.y + ro + 512 * j);
    }
}
template <bool XIN16, bool XOUT16> __device__ __forceinline__ void norm_process(NormRow& R, const NormArgs& A, int m, int lane) {
    const int b = m >> 12; const size_t ro = (size_t)m * D_ + 8 * lane;
    if (XIN16) {
#pragma unroll
        for (int j = 0; j < 4; ++j) { const bf16x8 v = *reinterpret_cast<const bf16x8*>(&R.x[2 * j]); bf8_to_f32(v, R.x[2 * j], R.x[2 * j + 1]); }
    }
    if (A.y) {
        f32x4 yv[8]; float ss = 0.f;
#pragma unroll
        for (int j = 0; j < 4; ++j) bf8_to_f32(R.y[j], yv[2 * j], yv[2 * j + 1]);
#pragma unroll
        for (int j = 0; j < 8; ++j) ss += (yv[j][0] * yv[j][0] + yv[j][1] * yv[j][1]) + (yv[j][2] * yv[j][2] + yv[j][3] * yv[j][3]);
        const float r = 1.0f / sqrtf(wave_sum(ss) * (1.0f / D_) + EPS);
#pragma unroll
        for (int j = 0; j < 8; ++j) { const int col = 8 * lane + 512 * (j >> 1) + 4 * (j & 1); const f32x4 gv = *(const f32x4*)(A.gate + (size_t)b * 12288 + col), nv = *(const f32x4*)(A.ng_y + col);
            R.x[j] = R.x[j] + gv * ((yv[j] * r) * nv);
            if (!XOUT16) *(f32x4*)((float*)A.xout + ro + 512 * (j >> 1) + 4 * (j & 1)) = R.x[j]; }
        if (XOUT16) {
#pragma unroll
            for (int j = 0; j < 4; ++j) { u32x4 w; w.x = cvtpk(R.x[2 * j][0], R.x[2 * j][1]); w.y = cvtpk(R.x[2 * j][2], R.x[2 * j][3]); w.z = cvtpk(R.x[2 * j + 1][0], R.x[2 * j + 1][1]); w.w = cvtpk(R.x[2 * j + 1][2], R.x[2 * j + 1][3]);
                *(u32x4*)((bf16*)A.xout + ro + 512 * j) = w;
                bf8_to_f32(*reinterpret_cast<const bf16x8*>(&w), R.x[2 * j], R.x[2 * j + 1]); }
        }
    }
    if (A.h || A.hk) {
        float ss = 0.f;
#pragma unroll
        for (int j = 0; j < 8; ++j) ss += (R.x[j][0] * R.x[j][0] + R.x[j][1] * R.x[j][1]) + (R.x[j][2] * R.x[j][2] + R.x[j][3] * R.x[j][3]);
        const float r = 1.0f / sqrtf(wave_sum(ss) * (1.0f / D_) + EPS);
        if (A.h) {
#pragma unroll
            for (int j = 0; j < 4; ++j) { const int col = 8 * lane + 512 * j; u32x4 w;
                { const f32x4 nv = *(const f32x4*)(A.ng_h + col), sv = *(const f32x4*)(A.sc + (size_t)b * 12288 + col), hv = *(const f32x4*)(A.sh + (size_t)b * 12288 + col);
                  const f32x4 o = ((R.x[2 * j] * r) * nv) * (sv + 1.0f) + hv; w.x = cvtpk(o[0], o[1]); w.y = cvtpk(o[2], o[3]); }
                { const f32x4 nv = *(const f32x4*)(A.ng_h + col + 4), sv = *(const f32x4*)(A.sc + (size_t)b * 12288 + col + 4), hv = *(const f32x4*)(A.sh + (size_t)b * 12288 + col + 4);
                  const f32x4 o = ((R.x[2 * j + 1] * r) * nv) * (sv + 1.0f) + hv; w.z = cvtpk(o[0], o[1]); w.w = cvtpk(o[2], o[3]); }
                *(u32x4*)(A.h + ro + 512 * j) = w; }
        }
        if (A.hk) {
#pragma unroll
            for (int j = 0; j < 4; ++j) { const int col = 8 * lane + 512 * j; u32x4 w;
                { const f32x4 nv = *(const f32x4*)(A.ng_k + col), sv = *(const f32x4*)(A.ksc + (size_t)b * 4096 + col), hv = *(const f32x4*)(A.ksh + (size_t)b * 4096 + col);
                  const f32x4 o = ((R.x[2 * j] * r) * nv) * (sv + 1.0f) + hv; w.x = cvtpk(o[0], o[1]); w.y = cvtpk(o[2], o[3]); }
                { const f32x4 nv = *(const f32x4*)(A.ng_k + col + 4), sv = *(const f32x4*)(A.ksc + (size_t)b * 4096 + col + 4), hv = *(const f32x4*)(A.ksh + (size_t)b * 4096 + col + 4);
                  const f32x4 o = ((R.x[2 * j + 1] * r) * nv) * (sv + 1.0f) + hv; w.z = cvtpk(o[0], o[1]); w.w = cvtpk(o[2], o[3]); }
                *(u32x4*)(A.hk + ro + 512 * j) = w; }
        }
    }
}
template <bool XIN16, bool XOUT16> __device__ __forceinline__ void norm_process_r(NormRow& R, const NormArgs& A, int m, int lane, const f32x4 (&pa)[8], const f32x4 (&pm)[8], const LAS float* lv) {
    const int b = m >> 12; const size_t ro = (size_t)m * D_ + 8 * lane;
    if (XIN16) {
#pragma unroll
        for (int j = 0; j < 4; ++j) { const bf16x8 v = *reinterpret_cast<const bf16x8*>(&R.x[2 * j]); bf8_to_f32(v, R.x[2 * j], R.x[2 * j + 1]); }
    }
    if (A.y) {
        f32x4 yv[8]; float ss = 0.f;
#pragma unroll
        for (int j = 0; j < 4; ++j) bf8_to_f32(R.y[j], yv[2 * j], yv[2 * j + 1]);
#pragma unroll
        for (int j = 0; j < 8; ++j) ss += (yv[j][0] * yv[j][0] + yv[j][1] * yv[j][1]) + (yv[j][2] * yv[j][2] + yv[j][3] * yv[j][3]);
        const float r = 1.0f / sqrtf(wave_sum(ss) * (1.0f / D_) + EPS);
#pragma unroll
        for (int j = 0; j < 8; ++j) { R.x[j] = R.x[j] + pa[j] * (yv[j] * r);
            if (!XOUT16) *(f32x4*)((float*)A.xout + ro + 512 * (j >> 1) + 4 * (j & 1)) = R.x[j]; }
        if (XOUT16) {
#pragma unroll
            for (int j = 0; j < 4; ++j) { u32x4 w; w.x = cvtpk(R.x[2 * j][0], R.x[2 * j][1]); w.y = cvtpk(R.x[2 * j][2], R.x[2 * j][3]); w.z = cvtpk(R.x[2 * j + 1][0], R.x[2 * j + 1][1]); w.w = cvtpk(R.x[2 * j + 1][2], R.x[2 * j + 1][3]);
                *(u32x4*)((bf16*)A.xout + ro + 512 * j) = w;
                bf8_to_f32(*reinterpret_cast<const bf16x8*>(&w), R.x[2 * j], R.x[2 * j + 1]); }
        }
    }
    if (A.h || A.hk) {
        float ss = 0.f;
#pragma unroll
        for (int j = 0; j < 8; ++j) ss += (R.x[j][0] * R.x[j][0] + R.x[j][1] * R.x[j][1]) + (R.x[j][2] * R.x[j][2] + R.x[j][3] * R.x[j][3]);
        const float r = 1.0f / sqrtf(wave_sum(ss) * (1.0f / D_) + EPS);
        if (A.h) {
#pragma unroll
            for (int j = 0; j < 4; ++j) { u32x4 w; const LAS float* shp = lv + 8 * lane + 512 * j;
                { const f32x4 o = (R.x[2 * j] * r) * pm[2 * j] + *(const LAS f32x4*)shp; w.x = cvtpk(o[0], o[1]); w.y = cvtpk(o[2], o[3]); }
                { const f32x4 o = (R.x[2 * j + 1] * r) * pm[2 * j + 1] + *(const LAS f32x4*)(shp + 4); w.z = cvtpk(o[0], o[1]); w.w = cvtpk(o[2], o[3]); }
                *(u32x4*)(A.h + ro + 512 * j) = w; }
        }
        if (A.hk) {
#pragma unroll
            for (int j = 0; j < 4; ++j) { const int col = 8 * lane + 512 * j; u32x4 w;
                { const f32x4 o = (R.x[2 * j] * r) * *(const LAS f32x4*)(lv + 2048 + col) + *(const LAS f32x4*)(lv + 4096 + col); w.x = cvtpk(o[0], o[1]); w.y = cvtpk(o[2], o[3]); }
                { const f32x4 o = (R.x[2 * j + 1] * r) * *(const LAS f32x4*)(lv + 2048 + col + 4) + *(const LAS f32x4*)(lv + 4096 + col + 4); w.z = cvtpk(o[0], o[1]); w.w = cvtpk(o[2], o[3]); }
                *(u32x4*)(A.hk + ro + 512 * j) = w; }
        }
    }
}
template <bool XIN16, bool XOUT16>
__device__ __forceinline__ void norm_phase(Frame& F, const void* xin, const bf16* y, const float* gate, const float* ng_y, void* xout,
                                           const float* ng_h, const float* sh, const float* sc, bf16* h,
                                           const float* ng_k, const float* ksh, const float* ksc, bf16* hk) {
    const NormArgs A{xin, y, gate, ng_y, xout, ng_h, sh, sc, h, ng_k, ksh, ksc, hk};
    const int gw = blockIdx.x * NWAVES + F.wave, NGW = F.G * NWAVES, lane = F.lane;
    if (F.G == 256) {
        const int m0 = ((((int)blockIdx.x & 7) * 32 + ((int)blockIdx.x >> 3)) * NWAVES + F.wave) * 8, b = m0 >> 12;
        LAS float* lv = (LAS float*)F.lds;
        { const int c4 = 4 * F.tid;
          if (h) *(LAS f32x4*)(lv + c4) = *(const f32x4*)(sh + (size_t)b * 12288 + c4);
          if (hk) { *(LAS f32x4*)(lv + 2048 + c4) = *(const f32x4*)(ng_k + c4) * (*(const f32x4*)(ksc + (size_t)b * 4096 + c4) + 1.0f); *(LAS f32x4*)(lv + 4096 + c4) = *(const f32x4*)(ksh + (size_t)b * 4096 + c4); } }
        __syncthreads();
        f32x4 pa[8], pm[8];
#pragma unroll
        for (int j = 0; j < 8; ++j) { const int col = 8 * lane + 512 * (j >> 1) + 4 * (j & 1);
            pa[j] = y ? *(const f32x4*)(gate + (size_t)b * 12288 + col) * *(const f32x4*)(ng_y + col) : (f32x4){0.f, 0.f, 0.f, 0.f};
            pm[j] = h ? *(const f32x4*)(ng_h + col) * (*(const f32x4*)(sc + (size_t)b * 12288 + col) + 1.0f) : (f32x4){0.f, 0.f, 0.f, 0.f};
            }
        NormRow RA, RB;
        norm_load<XIN16>(RA, A, m0, lane);
#pragma unroll 1
        for (int k = 0; k < 8; k += 2) {
            norm_load<XIN16>(RB, A, m0 + k + 1, lane);
            norm_process_r<XIN16, XOUT16>(RA, A, m0 + k, lane, pa, pm, lv);
            if (k + 2 < 8) norm_load<XIN16>(RA, A, m0 + k + 2, lane);
            norm_process_r<XIN16, XOUT16>(RB, A, m0 + k + 1, lane, pa, pm, lv);
        }
        __syncthreads();
        return;
    }
    NormRow RA, RB;
    if (gw < M_) norm_load<XIN16>(RA, A, gw, lane);
    for (int m = gw; m < M_; m += 2 * NGW) {
        const int m2 = m + NGW, m3 = m + 2 * NGW;
        if (m2 < M_) norm_load<XIN16>(RB, A, m2, lane);
        norm_process<XIN16, XOUT16>(RA, A, m, lane);
        if (m3 < M_) norm_load<XIN16>(RA, A, m3, lane);
        if (m2 < M_) norm_process<XIN16, XOUT16>(RB, A, m2, lane);
    }
}

__device__ __forceinline__ void gate_phase(Frame& F, const bf16* H, const bf16* WG, const float* gate_b, float* GATES) {
    LAS float* red = (LAS float*)F.lds;
    const int r = F.lane & 31, hh = F.lane >> 5, w = F.wave, rt = w >> 2, kq = w & 3, wrow = F.lane >> 3, wpc = F.lane & 7;
    LAS char* abuf = (LAS char*)F.lds + 65536 + w * 4608;
    for (int it = blockIdx.x; it < M_ / 64; it += F.G) {
        const int row0 = it * 64;
        const bf16* ap = H + (size_t)(row0 + 32 * rt + wrow) * D_ + kq * 512 + 8 * wpc;
        const bf16* bp = WG + ((size_t)(kq * 8) * 4 * 64 + F.lane) * 8;
        f32x16 a0 = {}, a1 = {};
#define GT_LD(S, ch) bf16x8 S##_a[4], S##_p[4], S##_q[4]; _Pragma("unroll") for (int j = 0; j < 4; ++j) { S##_a[j] = *(const bf16x8*)(ap + (size_t)(8 * j) * D_ + 64 * (ch)); \
            S##_p[j] = *(const bf16x8*)(bp + ((size_t)(ch) * 4 + j) * 512); S##_q[j] = *(const bf16x8*)(bp + (size_t)32 * 4 * 512 + ((size_t)(ch) * 4 + j) * 512); }
#define GT_MM(S) { _Pragma("unroll") for (int j = 0; j < 4; ++j) *(LAS bf16x8*)(abuf + (wrow + 8 * j) * 144 + wpc * 16) = S##_a[j]; \
            bf16x8 af[4]; _Pragma("unroll") for (int j = 0; j < 4; ++j) af[j] = *(const LAS bf16x8*)(abuf + r * 144 + (4 * hh + j) * 16); \
            _Pragma("unroll") for (int j = 0; j < 4; ++j) { a0 = __builtin_amdgcn_mfma_f32_32x32x16_bf16(af[j], S##_p[j], a0, 0, 0, 0); a1 = __builtin_amdgcn_mfma_f32_32x32x16_bf16(af[j], S##_q[j], a1, 0, 0, 0); } }
        GT_LD(c0, 0) GT_LD(c1, 1)
        GT_LD(c2, 2) GT_MM(c0) GT_LD(c3, 3) GT_MM(c1) GT_LD(c4, 4) GT_MM(c2) GT_LD(c5, 5) GT_MM(c3) GT_LD(c6, 6) GT_MM(c4) GT_LD(c7, 7) GT_MM(c5) GT_MM(c6) GT_MM(c7)
#undef GT_LD
#undef GT_MM
#pragma unroll
        for (int i = 0; i < 16; ++i) { red[((w * 2 + 0) * 16 + i) * 64 + F.lane] = a0[i]; red[((w * 2 + 1) * 16 + i) * 64 + F.lane] = a1[i]; }
        __syncthreads();
        for (int e = F.tid; e < 4096; e += NTHR) { const int ln = e & 63, i = (e >> 6) & 15, ct = (e >> 10) & 1, rt2 = e >> 11;
            float v = 0.f;
#pragma unroll
            for (int q = 0; q < 4; ++q) v += red[(((rt2 * 4 + q) * 2 + ct) * 16 + i) * 64 + ln];
            const int col = 32 * ct + (ln & 31), row = row0 + 32 * rt2 + (i & 3) + 8 * (i >> 2) + 4 * (ln >> 5);
            if (col < 48) GATES[(size_t)row * 48 + col] = 1.0f / (1.0f + __expf(-(v + gate_b[col]))); }
        __syncthreads();
    }
}

__device__ __forceinline__ void compress_phase(Frame& F, const bf16* KV6, const bf16* WC1, const bf16* WC2, const float* PEB, bf16* KCMP) {
    LAS char* ldsb = (LAS char*)F.lds;
    LAS bf16* Hs = (LAS bf16*)F.lds;
    const int r = F.lane & 31, hh = F.lane >> 5, w = F.wave;
    for (int u = blockIdx.x; u < 256; u += F.G) {
        const int t = u >> 7, b = (u >> 5) & 3, g = (u >> 3) & 3, n0 = (u & 7) * 32;
        const bf16* src = KV6 + (size_t)t * M_ * 512 + (size_t)b * S_ * 512 + g * 128;
        { bf16x8 v[17];
#pragma unroll
          for (int i = 0; i < 17; ++i) { const int q = F.tid + 512 * i, row = q >> 4, c = q & 15; int tok = 16 * n0 + row; tok = tok > S_ - 1 ? S_ - 1 : tok;
              if (q < 528 * 16) v[i] = *(const bf16x8*)(src + (size_t)tok * 512 + c * 8); }
#pragma unroll
          for (int i = 0; i < 17; ++i) { const int q = F.tid + 512 * i, row = q >> 4, c = q & 15;
              if (q < 528 * 16) *(LAS bf16x8*)(ldsb + row * 256 + ((c ^ ((row >> 4) & 15)) << 4)) = v[i]; } }
        __syncthreads();
        const bf16* wfrag = WC1 + (size_t)t * 256 * 4096 + ((size_t)w * 256 * 64 + F.lane) * 8;
        f32x16 acc = {};
        bf16x8 b0[8], b1[8];
#pragma unroll
        for (int dd = 0; dd < 8; ++dd) b0[dd] = *(const bf16x8*)(wfrag + (size_t)dd * 512);
#define CMP_STEP(LT, BC, BN) do { const int lt_ = (LT); \
            if (lt_ + 1 < 32) { _Pragma("unroll") for (int dd = 0; dd < 8; ++dd) BN[dd] = *(const bf16x8*)(wfrag + (size_t)((lt_ + 1) * 8 + dd) * 512); } \
            const int row = 16 * r + lt_; const LAS char* arow = ldsb + row * 256; const int key = (row >> 4) & 15; \
            _Pragma("unroll") for (int dd = 0; dd < 8; ++dd) { const bf16x8 af = *(const LAS bf16x8*)(arow + (((2 * dd + hh) ^ key) << 4)); \
                acc = __builtin_amdgcn_mfma_f32_32x32x16_bf16(af, BC[dd], acc, 0, 0, 0); } } while (0)
        for (int lt = 0; lt < 32; lt += 2) { CMP_STEP(lt, b0, b1); CMP_STEP(lt + 1, b1, b0); }
#undef CMP_STEP
        __syncthreads();
        const float pb = PEB[t * 256 + 32 * w + r];
#pragma unroll
        for (int i = 0; i < 16; ++i) { const int row = (i & 3) + 8 * (i >> 2) + 4 * hh; const float x = acc[i] + pb;
            const float u2 = 1.5957691216057308f * (x + 0.044715f * x * x * x);
            const float gl = x / (1.0f + __expf(-u2));
            Hs[row * 264 + 32 * w + r] = (bf16)(cvtpk(gl, 0.f) & 0xffffu); }
        __syncthreads();
        if (w < 4) {
            f32x16 a2 = {};
            const bf16* w2row = WC2 + (size_t)t * 128 * 256 + (size_t)(32 * w + r) * 256 + 8 * hh;
#pragma unroll
            for (int ks = 0; ks < 16; ++ks) {
                const bf16x8 af = *(const LAS bf16x8*)(Hs + r * 264 + 16 * ks + 8 * hh);
                const bf16x8 bfr = *(const bf16x8*)(w2row + 16 * ks);
                a2 = __builtin_amdgcn_mfma_f32_32x32x16_bf16(af, bfr, a2, 0, 0, 0);
            }
            bf16* dst = KCMP + ((size_t)(t * 16 + b * 4 + g) * NCP) * HD + 32 * w + r;
#pragma unroll
            for (int i = 0; i < 16; ++i) { const int n = n0 + (i & 3) + 8 * (i >> 2) + 4 * hh;
                dst[(size_t)n * HD] = (n < 255) ? (bf16)(cvtpk(a2[i], 0.f) & 0xffffu) : (bf16)0; }
        }
        __syncthreads();
    }
}

#define KSWZ(row, colB) ((row) * 256 + ((colB) ^ (((row) & 7) << 4)))
constexpr int SHM_K = 16384, SHM_V = 16384;
__device__ __forceinline__ int v_st(int k, int c) { const int kk = (k & ~0xC) | ((k & 4) << 1) | ((k & 8) >> 1); return ((kk >> 3) * 4 + (c >> 5)) * 512 + ((kk & 7) * 32 + (c & 31)) * 2; }
__device__ __forceinline__ int v_rd_base(int lane) { return ((lane & 3) << 3) | (((lane >> 2) & 3) << 6) | (((lane >> 4) & 1) << 5) | (((lane >> 5) & 1) << 8); }
constexpr int v_rd_off(int d0, int ks, int half) { return d0 * 512 + ks * 4096 + half * 2048; }
__device__ __forceinline__ int crow(int r, int hi) { return (r & 3) + 8 * (r >> 2) + 4 * hi; }
__device__ __forceinline__ float xhalf(float v, int hi) {
    auto rr = __builtin_amdgcn_permlane32_swap(__float_as_uint(v), __float_as_uint(v), false, false);
    return __uint_as_float(hi ? rr[0] : rr[1]);
}
struct StageRegs { bf16x8 k0, k1, v0, v1; };
template <bool DOV> __device__ __forceinline__ void stage_load(StageRegs& s, const bf16* K, const bf16* V, int stride, int key0, int sr, int sc) {
    s.k0 = *(const bf16x8*)(K + (size_t)(key0 + sr) * stride + sc); s.k1 = *(const bf16x8*)(K + (size_t)(key0 + 32 + sr) * stride + sc);
    if (DOV) { s.v0 = *(const bf16x8*)(V + (size_t)(key0 + sr) * stride + sc); s.v1 = *(const bf16x8*)(V + (size_t)(key0 + 32 + sr) * stride + sc); }
}
template <bool DOV> __device__ __forceinline__ void stage_write(const StageRegs& s, LAS char* Kb, LAS char* Vb, int sr, int sc) {
    const int kws = KSWZ(sr, sc * 2);
    *(LAS bf16x8*)(Kb + kws) = s.k0; *(LAS bf16x8*)(Kb + kws + 32 * 256) = s.k1;
    if (DOV) { *(LAS bf16x8*)(Vb + v_st(sr, sc)) = s.v0; *(LAS bf16x8*)(Vb + v_st(32 + sr, sc)) = s.v1; }
}
__device__ __forceinline__ void qkt(f32x16& p0, f32x16& p1, const LAS char* Kb, int r32, int hi, const bf16x8 (&qr)[8]) {
    p0 = f32x16{}; p1 = f32x16{};
    const LAS char* kb[4];
#pragma unroll
    for (int dd = 0; dd < 4; ++dd) kb[dd] = Kb + KSWZ(r32, (dd * 16 + hi * 8) * 2);
#define QK_RD(B, d0a) const bf16x8 B##0 = *(const LAS bf16x8*)(kb[(d0a) & 3] + ((d0a) >> 2) * 128), B##1 = *(const LAS bf16x8*)(kb[(d0a) & 3] + ((d0a) >> 2) * 128 + 32 * 256), \
                      B##2 = *(const LAS bf16x8*)(kb[((d0a) + 1) & 3] + (((d0a) + 1) >> 2) * 128), B##3 = *(const LAS bf16x8*)(kb[((d0a) + 1) & 3] + (((d0a) + 1) >> 2) * 128 + 32 * 256)
#define QK_MM(B, d0a) do { p0 = __builtin_amdgcn_mfma_f32_32x32x16_bf16(B##0, qr[d0a], p0, 0, 0, 0); p1 = __builtin_amdgcn_mfma_f32_32x32x16_bf16(B##1, qr[d0a], p1, 0, 0, 0); \
                           p0 = __builtin_amdgcn_mfma_f32_32x32x16_bf16(B##2, qr[(d0a) + 1], p0, 0, 0, 0); p1 = __builtin_amdgcn_mfma_f32_32x32x16_bf16(B##3, qr[(d0a) + 1], p1, 0, 0, 0); } while (0)
    QK_RD(ka, 0); QK_RD(kc, 2); SBAR();
    QK_MM(ka, 0); QK_RD(ke, 4); SBAR();
    QK_MM(kc, 2); QK_RD(kg, 6); SBAR();
    QK_MM(ke, 4); SBAR();
    QK_MM(kg, 6);
#undef QK_RD
#undef QK_MM
}
__device__ __forceinline__ void pack_p(const f32x16& p0, const f32x16& p1, bf16x8& pa0, bf16x8& pa1, bf16x8& pa2, bf16x8& pa3) {
#define PK4(P, B_, OUT) do { unsigned a0 = cvtpk(P[B_+0], P[B_+1]), a1 = cvtpk(P[B_+2], P[B_+3]);                          \
        unsigned b0 = cvtpk(P[B_+4], P[B_+5]), b1 = cvtpk(P[B_+6], P[B_+7]);                                             \
        auto r0 = __builtin_amdgcn_permlane32_swap(a0, b0, false, false); auto r1 = __builtin_amdgcn_permlane32_swap(a1, b1, false, false); \
        u32x4 w = {r0[0], r1[0], r0[1], r1[1]}; OUT = *reinterpret_cast<bf16x8*>(&w); } while (0)
    PK4(p0, 0, pa0); PK4(p0, 8, pa1); PK4(p1, 0, pa2); PK4(p1, 8, pa3);
#undef PK4
}
__device__ __forceinline__ void pv_tile(f32x16 (&o)[4], int vb, bf16x8 pa0, bf16x8 pa1, bf16x8 pa2, bf16x8 pa3) {
    const LAS char* vp = (const LAS char*)(uintptr_t)(unsigned)vb;
#define TRRD(off) __builtin_amdgcn_ds_read_tr16_b64_v4i16((LAS s16x4*)(vp + (off)))
#define TRB(off) __builtin_shufflevector(TRRD(off), TRRD((off) + 2048), 0, 1, 2, 3, 4, 5, 6, 7)
#define PV_D0(d0) do { constexpr int b_ = v_rd_off(d0, 0, 0); \
        const bf16x8 v0 = TRB(b_), v1 = TRB(b_ + 4096), v2 = TRB(b_ + 8192), v3 = TRB(b_ + 12288); \
        o[d0] = __builtin_amdgcn_mfma_f32_32x32x16_bf16(pa0, v0, o[d0], 0, 0, 0);   \
        o[d0] = __builtin_amdgcn_mfma_f32_32x32x16_bf16(pa1, v1, o[d0], 0, 0, 0);   \
        o[d0] = __builtin_amdgcn_mfma_f32_32x32x16_bf16(pa2, v2, o[d0], 0, 0, 0);   \
        o[d0] = __builtin_amdgcn_mfma_f32_32x32x16_bf16(pa3, v3, o[d0], 0, 0, 0); } while (0)
    PV_D0(0); PV_D0(1); PV_D0(2); PV_D0(3);
#undef PV_D0
#undef TRB
#undef TRRD
}

template <int MODE, bool IMP, bool DOPV>
__device__ __forceinline__ void attn_pass(Frame& F, LAS char* lds, const bf16* K, const bf16* V, int stride, unsigned long long tiles,
                                          const bf16x8 (&qr)[8], int klo, int khi, int u_klo_max, int u_khi_min, unsigned long long bmask, float& m, float& l, float rl, float gate,
                                          f32x16 (&o)[4], LAS float* impA, LAS float* impB, int tokl, LAS float* alw) {
    if (tiles == 0ull) return;
    constexpr bool NEEDV = (MODE == 2) || (MODE == 1 && DOPV);
    int tid_ = F.tid; asm volatile("" : "+v"(tid_));
    const int lane = tid_ & 63, r32 = lane & 31, hi = lane >> 5, sr = tid_ >> 4, sc = (tid_ & 15) * 8;
    const int vb0 = (int)(uintptr_t)(lds + 2 * SHM_K) + v_rd_base(lane);
    const float NEG = -__builtin_inff();
    StageRegs st;
    int j = __builtin_ctzll(tiles); tiles &= tiles - 1;
    stage_load<NEEDV>(st, K, V, stride, j * 64, sr, sc);
    stage_write<NEEDV>(st, lds, lds + 2 * SHM_K, sr, sc);
    __syncthreads();
    int buf = 0;
    for (;;) {
        const bool more = tiles != 0ull; int jn = 0;
        if (more) { jn = __builtin_ctzll(tiles); tiles &= tiles - 1; stage_load<NEEDV>(st, K, V, stride, jn * 64, sr, sc); }
        f32x16 p0, p1;
        qkt(p0, p1, lds + buf * SHM_K, r32, hi, qr);
        const bool bit = (bmask >> j) & 1ull;
        if (j * 64 < u_klo_max || j * 64 + 63 > u_khi_min) {
            const int kb = j * 64 + 4 * hi;
#pragma unroll
            for (int r = 0; r < 16; ++r) { const int k0 = kb + (r & 3) + 8 * (r >> 2), k1 = k0 + 32;
                if (!(k0 >= klo && k0 <= khi)) p0[r] = NEG;
                if (!(k1 >= klo && k1 <= khi)) p1[r] = NEG; }
        }
        if (MODE == 0 || MODE == 2) {
            float tmax = p0[0];
#pragma unroll
            for (int r = 1; r < 16; ++r) tmax = fmaxf(tmax, p0[r]);
#pragma unroll
            for (int r = 0; r < 16; ++r) tmax = fmaxf(tmax, p1[r]);
            tmax = bit ? tmax : NEG;
            tmax = fmaxf(tmax, xhalf(tmax, hi));
            if (MODE == 0) {
                const float mn = fmaxf(m, tmax), mb = bit ? -mn * C2 : NEG;
                float ps = 0.f;
#pragma unroll
                for (int r = 0; r < 16; ++r) ps += __builtin_amdgcn_exp2f(fmaf(p0[r], C2, mb)) + __builtin_amdgcn_exp2f(fmaf(p1[r], C2, mb));
                ps += xhalf(ps, hi);
                l = l * __builtin_amdgcn_exp2f((m - mn) * C2) + ps; m = mn;
            } else {
                if (!__all((tmax - m) * SCALE <= 8.0f)) {
                    const float mn = fmaxf(m, tmax), alpha = __builtin_amdgcn_exp2f((m - mn) * C2);
                    l *= alpha; m = mn;
                    if (hi == 0) alw[r32] = alpha;
#pragma unroll
                    for (int r = 0; r < 16; ++r) { const float al = alw[crow(r, hi)];
#pragma unroll
                        for (int d0 = 0; d0 < 4; ++d0) o[d0][r] *= al; }
                }
                const float mb = bit ? -m * C2 : NEG;
                float ps = 0.f;
#pragma unroll
                for (int r = 0; r < 16; ++r) { p0[r] = __builtin_amdgcn_exp2f(fmaf(p0[r], C2, mb)); p1[r] = __builtin_amdgcn_exp2f(fmaf(p1[r], C2, mb)); ps += p0[r] + p1[r]; }
                ps += xhalf(ps, hi);
                l += ps;
                bf16x8 pa0, pa1, pa2, pa3;
                pack_p(p0, p1, pa0, pa1, pa2, pa3);
                pv_tile(o, vb0 + buf * SHM_V, pa0, pa1, pa2, pa3);
            }
        } else {
            const float mb = bit ? -m * C2 : NEG;
#pragma unroll
            for (int r = 0; r < 16; ++r) { p0[r] = __builtin_amdgcn_exp2f(fmaf(p0[r], C2, mb)) * rl; p1[r] = __builtin_amdgcn_exp2f(fmaf(p1[r], C2, mb)) * rl; }
            if (IMP) {
#pragma unroll
                for (int pi = 0; pi < 2; ++pi)
#pragma unroll
                    for (int q = 0; q < 4; ++q) {
                        float qs, last;
                        if (pi == 0) { qs = (p0[4 * q] + p0[4 * q + 1]) + (p0[4 * q + 2] + p0[4 * q + 3]); last = p0[4 * q + 3]; }
                        else { qs = (p1[4 * q] + p1[4 * q + 1]) + (p1[4 * q + 2] + p1[4 * q + 3]); last = p1[4 * q + 3]; }
                        qs += lx1(qs); qs += lx2(qs); last += lx1(last); last += lx2(last);
                        const int mb_ = 16 * j + 8 * pi + 2 * q + hi;
                        if ((r32 & 3) == 0) { impA[tokl * 64 + mb_] = qs; if (mb_ + 1 < 64) impB[tokl * 64 + mb_ + 1] = last; }
                    }
            }
            if (DOPV) {
#pragma unroll
                for (int r = 0; r < 16; ++r) { p0[r] *= gate; p1[r] *= gate; }
                bf16x8 pa0, pa1, pa2, pa3;
                pack_p(p0, p1, pa0, pa1, pa2, pa3);
                pv_tile(o, vb0 + buf * SHM_V, pa0, pa1, pa2, pa3);
            }
        }
        if (more) stage_write<NEEDV>(st, lds + (buf ^ 1) * SHM_K, lds + 2 * SHM_K + (buf ^ 1) * SHM_V, sr, sc);
        __syncthreads();
        if (!more) break;
        j = jn; buf ^= 1;
    }
}

constexpr int NSA_IMP_OFF = 65536, NSA_MASK_OFF = 65536 + 32768, NSA_ALW_OFF = NSA_MASK_OFF + 1024, NSA_PK2_OFF = 106496;
__device__ __forceinline__ void nsa_attn_phase(Frame& F, const bf16* Q, const bf16* KV6, const bf16* KCMP, const float* GATES, bf16* O, float* STASH) {
    LAS char* lds = (LAS char*)F.lds;
    LAS float* impA = (LAS float*)(lds + NSA_IMP_OFF); LAS float* impB = impA + 4096;
    LAS unsigned long long* MASK = (LAS unsigned long long*)(lds + NSA_MASK_OFF);
    const int lane = F.lane, w = F.wave, r32 = lane & 31, hi = lane >> 5;
    LAS float* alw = (LAS float*)(lds + NSA_ALW_OFF) + w * 32;
    (void)STASH;
    if (w >= 4) __builtin_amdgcn_s_setprio(1);
    for (int i = 0;; ++i) {
        int qt, bg;
        if (F.G == 256) {
            if (i >= 4) break;
            const int x = blockIdx.x & 7, k = blockIdx.x >> 3;
            bg = x + 8 * (i >> 1); qt = (i & 1) ? k : 63 - k;
        } else {
            const int idx = i * F.G + ((i & 1) ? (F.G - 1 - (int)blockIdx.x) : (int)blockIdx.x);
            if (idx >= 1024) break;
            qt = 63 - (idx >> 4); bg = idx & 15;
        }
        const int b = bg >> 2, g = bg & 3, t0 = qt * 64;
        const int tw0 = t0 + 8 * w;
        const int tokl = 8 * w + (r32 >> 2), t = t0 + tokl, head = 4 * g + (r32 & 3);
        const size_t rowQ = (size_t)b * S_ + t;
        bf16x8 qr[8];
#pragma unroll
        for (int d0 = 0; d0 < 8; ++d0) qr[d0] = *(const bf16x8*)(Q + rowQ * D_ + head * HD + d0 * 16 + hi * 8);
        float g_all[3]; { const float* gp_ = GATES + rowQ * 48 + head * 3; g_all[0] = gp_[0]; g_all[1] = gp_[1]; g_all[2] = gp_[2]; }
#define NSA_GATE(k) (g_all[k])
        for (int e = F.tid; e < 8192; e += NTHR) impA[e] = 0.f;
        __syncthreads();
        f32x16 o[4] = {};
        const size_t kvb = (size_t)b * S_ * 512 + g * 128, TS = (size_t)M_ * 512;
        { const int nvalid = t >= 31 ? (t - 15) >> 4 : 0, ntc = (((t0 + 48) >> 4) + 63) >> 6;
          const int nv_min = tw0 >= 31 ? (tw0 - 15) >> 4 : 0;
          const unsigned long long tc = (1ull << ntc) - 1ull;
          const bf16* Kc = KCMP + (size_t)bg * NCP * HD; const bf16* Vc = KCMP + (size_t)(16 + bg) * NCP * HD;
          float m_c = -1e30f, l_c = 0.f;
          attn_pass<0, false, false>(F, lds, Kc, Vc, HD, tc, qr, 0, nvalid - 1, 0, nv_min - 1, ~0ull, m_c, l_c, 0.f, 0.f, o, impA, impB, tokl, alw);
          const float rl_c = l_c > 0.f ? 1.0f / l_c : 0.f;
          attn_pass<1, true, true>(F, lds, Kc, Vc, HD, tc, qr, 0, nvalid - 1, 0, nv_min - 1, ~0ull, m_c, l_c, rl_c, NSA_GATE(0), o, impA, impB, tokl, alw); }
        __syncthreads();
        int lnk = F.lane; asm volatile("" : "+v"(lnk));
        { const bool forced = (lnk == 0) || (lnk == qt) || (lnk == qt - 1), avail = lnk <= qt;
          LAS unsigned* kbuf = (LAS unsigned*)(lds + w * 2048);
#pragma unroll
          for (int u = 0; u < 8; ++u) { const int tok = 8 * w + u; const float v = impA[tok * 64 + lnk] + impB[tok * 64 + lnk];
              kbuf[u * 64 + lnk] = forced ? 0xFFFFFFFFu : (avail ? __float_as_uint(v) + 64u : (unsigned)(63 - lnk)); }
#pragma unroll 1
          for (int u = 0; u < 8; ++u) {
              const unsigned key = kbuf[u * 64 + lnk]; int rank = 0;
              const int nq = ((qt > 15 ? qt : 15) >> 2) + 1;
#pragma unroll 4
              for (int q = 0; q < nq; ++q) { const u32x4 o4 = *(const LAS u32x4*)(kbuf + u * 64 + 4 * q);
                  rank += (o4.x > key ? 1 : 0) + (o4.y > key ? 1 : 0) + (o4.z > key ? 1 : 0) + (o4.w > key ? 1 : 0); }
              unsigned long long sel = __ballot(rank < 16);
              if (__builtin_popcount((unsigned)sel) + __builtin_popcount((unsigned)(sel >> 32)) != 16) {
                  unsigned T = 0u;
#pragma unroll 1
                  for (int bit = 30; bit >= 0; --bit) { const unsigned c = T | (1u << bit); const unsigned long long bl = __ballot(key >= c);
                      if (__builtin_popcount((unsigned)bl) + __builtin_popcount((unsigned)(bl >> 32)) >= 16) T = c; }
                  const unsigned long long gt = __ballot(key > T), eq = __ballot(key == T);
                  const int need = 16 - (__builtin_popcount((unsigned)gt) + __builtin_popcount((unsigned)(gt >> 32)));
                  const int pos = (int)__builtin_amdgcn_mbcnt_hi((unsigned)(eq >> 32), __builtin_amdgcn_mbcnt_lo((unsigned)eq, 0u));
                  sel = __ballot(key > T || (key == T && pos < need));
              }
              if (lnk == 0) MASK[8 * w + u] = sel; }
        }
        __syncthreads();
        const unsigned long long ts = (qt == 63) ? ~0ull : ((1ull << (qt + 1)) - 1ull);
#define NSA_PK(k) (*(LAS unsigned*)(lds + ((k) < 16 ? NSA_IMP_OFF + (k) * 2048 : NSA_PK2_OFF + ((k) - 16) * 2048) + stid * 4))
        const unsigned long long mymask0 = MASK[tokl];
        int stid = F.tid; asm volatile("" : "+v"(stid));
#pragma unroll
        for (int d0 = 0; d0 < 4; ++d0)
#pragma unroll
            for (int r2 = 0; r2 < 8; ++r2) NSA_PK(d0 * 8 + r2) = cvtpk(o[d0][2 * r2], o[d0][2 * r2 + 1]);
#pragma unroll
        for (int d0 = 0; d0 < 4; ++d0) o[d0] = f32x16{};
        { const unsigned long long mymask = mymask0;
          const bf16* Ks = KV6 + 2 * TS + kvb; const bf16* Vs = KV6 + 3 * TS + kvb;
          float m = -1e30f, l = 0.f;
          attn_pass<2, false, true>(F, lds, Ks, Vs, 512, ts, qr, 0, t, 0, tw0, mymask, m, l, 0.f, 0.f, o, impA, impB, tokl, alw);
          const float f = l > 0.f ? NSA_GATE(1) / l : 0.f;
          if (hi == 0) alw[r32] = f;
          float al[16];
#pragma unroll
          for (int r = 0; r < 16; ++r) al[r] = alw[crow(r, hi)];
#pragma unroll
          for (int d0 = 0; d0 < 4; ++d0)
#pragma unroll
              for (int r2 = 0; r2 < 8; ++r2) { const unsigned w_ = NSA_PK(d0 * 8 + r2);
                  const float a = o[d0][2 * r2] * al[2 * r2] + __uint_as_float(w_ << 16), c = o[d0][2 * r2 + 1] * al[2 * r2 + 1] + __uint_as_float(w_ & 0xffff0000u);
                  NSA_PK(d0 * 8 + r2) = cvtpk(a, c); }
#pragma unroll
          for (int d0 = 0; d0 < 4; ++d0) o[d0] = f32x16{}; }
        { const bf16* Kw = KV6 + 4 * TS + kvb; const bf16* Vw = KV6 + 5 * TS + kvb;
          const int jlo = qt >= 8 ? qt - 8 : 0; const unsigned long long tw = ts & ~((1ull << jlo) - 1ull);
          float m = -1e30f, l = 0.f;
          attn_pass<2, false, true>(F, lds, Kw, Vw, 512, tw, qr, t - 511, t, tw0 + 7 - 511, tw0, ~0ull, m, l, 0.f, 0.f, o, impA, impB, tokl, alw);
          const float f = l > 0.f ? NSA_GATE(2) / l : 0.f;
          if (hi == 0) alw[r32] = f;
          float al[16];
#pragma unroll
          for (int r = 0; r < 16; ++r) al[r] = alw[crow(r, hi)];
#pragma unroll
          for (int d0 = 0; d0 < 4; ++d0)
#pragma unroll
              for (int r2 = 0; r2 < 8; ++r2) { const unsigned w_ = NSA_PK(d0 * 8 + r2);
                  o[d0][2 * r2] = o[d0][2 * r2] * al[2 * r2] + __uint_as_float(w_ << 16); o[d0][2 * r2 + 1] = o[d0][2 * r2 + 1] * al[2 * r2 + 1] + __uint_as_float(w_ & 0xffff0000u); } }
        int ln2 = F.lane; asm volatile("" : "+v"(ln2)); const int r32s = ln2 & 31, his = ln2 >> 5;
        LAS char* ost = lds + w * 8192;
#pragma unroll
        for (int r = 0; r < 16; ++r) { LAS char* op = ost + crow(r, his) * 256 + r32s * 2;
#pragma unroll
            for (int d0 = 0; d0 < 4; ++d0) { const float v = o[d0][r], vn = lx1(v); if ((r32s & 1) == 0) *(LAS unsigned*)(op + d0 * 64) = cvtpk(v, vn); } }
        { bf16* ob = O + ((size_t)b * S_ + t0 + 8 * w) * D_ + (size_t)(4 * g) * HD + ln2 * 8;
#pragma unroll
          for (int i = 0; i < 8; ++i) { const u32x4 v = *(const LAS u32x4*)(ost + i * 1024 + ln2 * 16); *(u32x4*)(ob + (size_t)i * D_) = v; } }
    }
    __builtin_amdgcn_s_setprio(0);
}

constexpr int SB_DONE_OFF = 65536;
constexpr float SB_EPS = 9.094947e-13f;
__device__ __forceinline__ void sb_attn_phase(Frame& F, const bf16* Q, const bf16* Ksh, const bf16* Vsh, bf16* O) {
    LAS char* lds = (LAS char*)F.lds;
    LAS unsigned* DONE = (LAS unsigned*)(lds + SB_DONE_OFF);
    const int lane = F.lane, w = F.wave, r32 = lane & 31, hi = lane >> 5, sr = F.tid >> 4, sc = (F.tid & 15) * 8;
    const int vb0 = (int)(uintptr_t)(lds + 2 * SHM_K) + v_rd_base(lane);
    if (w >= 4) __builtin_amdgcn_s_setprio(1);
    for (int ui = 0, u0 = blockIdx.x; u0 < 1024; ++ui, u0 += F.G) {
        int u = u0;
        if (F.G == 256) { const int x = blockIdx.x & 7, q = ui * 32 + (blockIdx.x >> 3); u = ((x + 8 * (q >> 4)) << 4) | (q & 15); }
        const int qb = u & 15, bh = u >> 4, b = bh >> 4, h = bh & 15, t0 = qb * 256, rlo = t0 + 32 * w, t = rlo + r32;
        bf16x8 qr[8];
#pragma unroll
        for (int d0 = 0; d0 < 8; ++d0) qr[d0] = *(const bf16x8*)(Q + ((size_t)b * S_ + t) * D_ + h * HD + d0 * 16 + hi * 8);
        const bf16* Kp = Ksh + (size_t)b * S_ * D_ + h * HD; const bf16* Vp = Vsh + (size_t)b * S_ * D_ + h * HD;
        float carry = 1.0f; f32x16 o[4] = {};
        int j = (t0 >> 6) + 3, buf = 0, it = 0;
        StageRegs st;
        stage_load<true>(st, Kp, Vp, D_, j * 64, sr, sc);
        stage_write<true>(st, lds, lds + 2 * SHM_K, sr, sc);
        __syncthreads();
        for (;;) {
            const bool more = j > 0;
            if (more) stage_load<true>(st, Kp, Vp, D_, (j - 1) * 64, sr, sc);
            const int kb = j * 64;
            const bool wdone = __all(carry < SB_EPS);
            if (kb <= rlo + 30 && !wdone) {
                f32x16 p0, p1;
                qkt(p0, p1, lds + buf * SHM_K, r32, hi, qr);
                f32x16 om0, om1; const int kq = kb + 4 * hi;
                constexpr float SBK = -SCALE * 1.4426950408889634f, SBZ = 80.f * 1.4426950408889634f;
                if (kb + 63 < rlo) {
#pragma unroll
                    for (int r = 0; r < 16; ++r) {
                        { float y = p0[r] * SBK; y = fminf(fmaxf(y, -SBZ), SBZ); const float e = __builtin_amdgcn_exp2f(y), be = __builtin_amdgcn_rcpf(1.0f + e); p0[r] = be; om0[r] = e * be; }
                        { float y = p1[r] * SBK; y = fminf(fmaxf(y, -SBZ), SBZ); const float e = __builtin_amdgcn_exp2f(y), be = __builtin_amdgcn_rcpf(1.0f + e); p1[r] = be; om1[r] = e * be; } }
                } else {
#pragma unroll
                    for (int r = 0; r < 16; ++r) { const int k0 = kq + (r & 3) + 8 * (r >> 2), k1 = k0 + 32;
                        { float y = p0[r] * SBK; y = fminf(fmaxf(y, -SBZ), SBZ); const float e = __builtin_amdgcn_exp2f(y), be = __builtin_amdgcn_rcpf(1.0f + e);
                          const bool c = k0 < t; p0[r] = c ? be : 0.f; om0[r] = c ? e * be : 1.0f; }
                        { float y = p1[r] * SBK; y = fminf(fmaxf(y, -SBZ), SBZ); const float e = __builtin_amdgcn_exp2f(y), be = __builtin_amdgcn_rcpf(1.0f + e);
                          const bool c = k1 < t; p1[r] = c ? be : 0.f; om1[r] = c ? e * be : 1.0f; } }
                }
                float acc = carry;
#pragma unroll
                for (int uu = 7; uu >= 0; --uu) { const int q = uu & 3;
                    float a0, a1, a2, a3;
                    if (uu >= 4) { a0 = om1[4 * q]; a1 = om1[4 * q + 1]; a2 = om1[4 * q + 2]; a3 = om1[4 * q + 3]; } else { a0 = om0[4 * q]; a1 = om0[4 * q + 1]; a2 = om0[4 * q + 2]; a3 = om0[4 * q + 3]; }
                    const float pm = (a0 * a1) * (a2 * a3), pp = xhalf(pm, hi);
                    acc *= hi ? 1.0f : pp;
                    const float s3 = acc, s2 = s3 * a3, s1 = s2 * a2, s0 = s1 * a1;
                    if (uu >= 4) { p1[4 * q] *= s0; p1[4 * q + 1] *= s1; p1[4 * q + 2] *= s2; p1[4 * q + 3] *= s3; } else { p0[4 * q] *= s0; p0[4 * q + 1] *= s1; p0[4 * q + 2] *= s2; p0[4 * q + 3] *= s3; }
                    acc *= pm; acc *= hi ? pp : 1.0f; }
                carry = acc;
                bf16x8 pa0, pa1, pa2, pa3;
                pack_p(p0, p1, pa0, pa1, pa2, pa3);
                pv_tile(o, vb0 + buf * SHM_V, pa0, pa1, pa2, pa3);
            }
            if (lane == 0) DONE[(it & 1) * 8 + w] = __all(carry < SB_EPS) ? 1u : 0u;
            if (more) stage_write<true>(st, lds + (buf ^ 1) * SHM_K, lds + 2 * SHM_K + (buf ^ 1) * SHM_V, sr, sc);
            __syncthreads();
            if (!more) break;
            unsigned alld = 1u;
#pragma unroll
            for (int ww = 0; ww < 8; ++ww) alld &= DONE[(it & 1) * 8 + ww];
            if (alld) break;
            --j; buf ^= 1; ++it;
        }
        __syncthreads();
        { LAS char* ost = lds + 73728 + w * 8192;
#pragma unroll
          for (int r = 0; r < 16; ++r) { LAS char* op = ost + crow(r, hi) * 256 + r32 * 2;
#pragma unroll
              for (int d0 = 0; d0 < 4; ++d0) { const float v = o[d0][r], vn = lx1(v); if ((r32 & 1) == 0) *(LAS unsigned*)(op + d0 * 64) = cvtpk(v, vn); } }
          bf16* ob = O + ((size_t)b * S_ + rlo + (lane >> 4)) * D_ + h * HD + (lane & 15) * 8;
#pragma unroll
          for (int i = 0; i < 8; ++i) { const u32x4 v = *(const LAS u32x4*)(ost + i * 1024 + lane * 16); *(u32x4*)(ob + (size_t)(4 * i) * D_) = v; } }
    }
    __builtin_amdgcn_s_setprio(0);
}


constexpr int NPHASE = 2 + 8 * NLAYER;
#ifndef MK_MULTI
#define MK_MULTI 0
#endif
#ifndef PHMASK
#define PHMASK 0xFFFF
#endif
#define PHSEL(b) ((PHMASK >> (b)) & 1)
#ifndef PROBE_REP
#define PROBE_REP 0
#endif
#define NREP(b) (1 + ((PROBE_REP >> (b)) & 1))
__global__ void __launch_bounds__(NTHR, 2) yoco_fwd(Args args) {
    extern __shared__ __attribute__((aligned(16))) unsigned char lds_raw[];
    Frame F;
    F.lds = (LAS unsigned char*)lds_raw;
    const int wave_s = __builtin_amdgcn_readfirstlane((int)threadIdx.x >> 6);
    F.tid = mk_tid(wave_s); F.lane = F.tid & 63; F.wave = wave_s;
    F.G = gridDim.x; F.vcu = blockIdx.x; F.ws = args.ws;
    unsigned char* ws = args.ws;
    unsigned* ctl = (unsigned*)(ws + WS_CTL);
    volatile LAS unsigned* MISC = (volatile LAS unsigned*)(F.lds + MISC_OFF);
    for (int u = F.tid; u < (LDS_BYTES - LDSCTL_OFF) / 4; u += NTHR) ((LAS unsigned*)(F.lds + LDSCTL_OFF))[u] = 0u;
    __syncthreads();
    const int lo = args.ph_lo, hi = args.ph_hi;
    XcdBarrier bar; bar.bar = ctl + CW_BAR; bar.x = 0; bar.st = nullptr;
    if (hi - lo > 1) bar = xcd_barrier_post(ctl + CW_BAR, MISC + 8, F.tid == 0);
#define IN(k) (lo <= (k) && (k) < hi)
#define SEAM(k) do { if ((k) + 1 < hi) xcd_barrier(bar, mk_tid(wave_s) == 0); } while (0)
#define GSEAM(k) do { if ((k) + 1 < hi) { if (lo == 0) group_barrier(bar, mk_tid(wave_s)); else xcd_barrier(bar, mk_tid(wave_s) == 0); } } while (0)

#define DEF_BUFS \
    const float* MODV = (const float*)(ws + WS_MODV); \
    const float* KVMOD = (const float*)(ws + WS_KVMOD); \
    bf16* Hb = (bf16*)(ws + WS_H); bf16* HKb = (bf16*)(ws + WS_HK); bf16* Qb = (bf16*)(ws + WS_Q); bf16* KV6 = (bf16*)(ws + WS_KV6); \
    float* GATES = (float*)(ws + WS_GATES); bf16* KCMP = (bf16*)(ws + WS_KCMP); bf16* Ob = (bf16*)(ws + WS_O); bf16* Yb = (bf16*)(ws + WS_Y); \
    bf16* ACTb = (bf16*)(ws + WS_ACT); bf16* KSH = (bf16*)(ws + WS_KSH); bf16* VSH = (bf16*)(ws + WS_VSH);
    DEF_BUFS
    const float* NORMG = args.in[I_NORMG];
    bf16* XB = (bf16*)(ws + WS_XB);

#if PHSEL(0)
    if (IN(0)) { for (int rep = 0; rep < NREP(0); ++rep) { p0_prologue(F, args); __syncthreads(); } SEAM(0); }
#endif
#if PHSEL(1)
    if (IN(1)) { norm_phase<false, true>(F, args.in[I_X], nullptr, nullptr, nullptr, nullptr, NORMG + 0, MODV + 0 * D_, MODV + 1 * D_, Hb, nullptr, nullptr, nullptr, nullptr); GSEAM(1); }
#endif

    for (int L = 0; L < NLAYER; ++L) {
        const int pb = 2 + 8 * L;
#define RETID() do { const int t_ = mk_tid(wave_s); F.tid = t_; F.lane = t_ & 63; F.wave = wave_s; } while (0)
        RETID();
        int bx_ = (int)blockIdx.x; asm volatile("" : "+s"(bx_));
        { GAS unsigned char* w_ = (GAS unsigned char*)args.ws; asm volatile("" : "+s"(w_)); ws = (unsigned char*)w_; F.ws = ws; }
        DEF_BUFS
        bf16* XB = (bf16*)(ws + WS_XB);
        const float* modL = MODV + (size_t)L * 4 * 12288;
        if (IN(pb + 0)) {
            RETID();
            if (L < 2) {
#if PHSEL(2)
                pg8::Gemm g{Hb, (const bf16*)(ws + WS_WAIN + L * SZ_WAIN), M_, NPROJ, D_}; pg8::StaticOrder S; S.init(M_, NPROJ, F.G, bx_);
                pg8::EpiNsaProj E{Qb, KV6, (const float*)(ws + WS_ROPE)};
                for (int rep = 0; rep < NREP(2); ++rep) pg8::gemm_phase<pg8::EpiNsaProj, pg8::StaticOrder, true, true>(F.lds, g, S, E, F.tid);
#endif

            } else {
#if PHSEL(3)
                { pg8::Gemm g{Hb, (const bf16*)(ws + WS_WBQ + (L - 2) * SZ_WSQ), M_, D_, D_}; pg8::StaticOrder S; S.init(M_, D_, F.G, bx_);
                  pg8::EpiBf16<0> E{Qb, D_, nullptr, 0, 0, 1.f};
                  for (int rep = 0; rep < NREP(3); ++rep) pg8::gemm_phase<pg8::EpiBf16<0>, pg8::StaticOrder, true, true>(F.lds, g, S, E, F.tid); }
                if (L == 2) {
                  __syncthreads();
                  pg8::Gemm g{HKb, (const bf16*)(ws + WS_WKV), M_, 2 * D_, D_}; pg8::StaticOrder S; S.init(M_, 2 * D_, F.G, bx_);
                  pg8::EpiBf16<0> E{KSH, D_, nullptr, D_, (size_t)(WS_VSH - WS_KSH) / 2, 1.f};
                  for (int rep = 0; rep < NREP(3); ++rep) pg8::gemm_phase<pg8::EpiBf16<0>, pg8::StaticOrder, true, true>(F.lds, g, S, E, F.tid); }
#endif
            }

            SEAM(pb + 0);
        }
        if (L < 2 && IN(pb + 1)) {
            RETID();
#if PHSEL(4)
            gate_phase(F, Hb, (const bf16*)(ws + WS_WG + L * SZ_WG), args.in[I_AGATEB] + L * 48, GATES);
            for (int rep = 0; rep < NREP(4); ++rep) compress_phase(F, KV6, (const bf16*)(ws + WS_WC1 + (size_t)(2 * L) * SZ_WC1), (const bf16*)(ws + WS_WC2 + (size_t)(2 * L) * SZ_WC2), (const float*)(ws + WS_PEB) + L * 512, KCMP);
#endif

            SEAM(pb + 1);
        }
        if (IN(pb + 2)) {
            RETID();
            if (L < 2) {
#if PHSEL(5)
                for (int rep = 0; rep < NREP(5); ++rep) nsa_attn_phase(F, Qb, KV6, KCMP, GATES, Ob, (float*)(ws + WS_STASH));
#endif
            } else {
#if PHSEL(6)
                for (int rep = 0; rep < NREP(6); ++rep) sb_attn_phase(F, Qb, KSH, VSH, Ob);
#endif
            }
            SEAM(pb + 2);
        }
        if (IN(pb + 3)) {
            RETID();
            const bf16* wo = (L < 2) ? (const bf16*)(ws + WS_WAOUT + L * SZ_WSQ) : (const bf16*)(ws + WS_WBOUT + (L - 2) * SZ_WSQ);
#if PHSEL(7)
            pg8::Gemm g{Ob, wo, M_, D_, D_}; pg8::StaticOrder S; S.init(M_, D_, F.G, bx_);
            pg8::EpiBf16<0> E{Yb, D_, nullptr, 0, 0, 1.f};
            for (int rep = 0; rep < NREP(7); ++rep) pg8::gemm_phase<pg8::EpiBf16<0>, pg8::StaticOrder, true, true>(F.lds, g, S, E, F.tid);
#endif

            GSEAM(pb + 3);
        }
        if (IN(pb + 4)) {
            RETID();
#if PHSEL(1)
            if (L == 0) norm_phase<false, true>(F, args.in[I_X], Yb, modL + 2 * D_, NORMG + (size_t)(L * 4 + 1) * D_, XB, NORMG + (size_t)(L * 4 + 2) * D_, modL + 3 * D_, modL + 4 * D_, Hb, nullptr, nullptr, nullptr, nullptr);
            else norm_phase<true, true>(F, XB, Yb, modL + 2 * D_, NORMG + (size_t)(L * 4 + 1) * D_, XB, NORMG + (size_t)(L * 4 + 2) * D_, modL + 3 * D_, modL + 4 * D_, Hb, nullptr, nullptr, nullptr, nullptr);
#endif

            GSEAM(pb + 4);
        }
        if (IN(pb + 5)) {
            RETID();
#if PHSEL(8)
            pg8::Gemm g{Hb, (const bf16*)(ws + WS_WFIN + L * SZ_WFIN), M_, 2 * DFF, D_}; pg8::StaticOrder S; S.init(M_, 2 * DFF, F.G, bx_);
            pg8::EpiSwiglu E{ACTb, DFF};
            for (int rep = 0; rep < NREP(8); ++rep) pg8::gemm_phase<pg8::EpiSwiglu, pg8::StaticOrder, true, true>(F.lds, g, S, E, F.tid);
#endif

            GSEAM(pb + 5);
        }
        if (IN(pb + 6)) {
            RETID();
#if PHSEL(9)
            pg8::Gemm g{ACTb, (const bf16*)(ws + WS_WFOUT + L * SZ_WFOUT), M_, D_, DFF}; pg8::StaticOrder S; S.init(M_, D_, F.G, bx_);
            pg8::EpiBf16<0> E{Yb, D_, nullptr, 0, 0, 1.f};
            for (int rep = 0; rep < NREP(9); ++rep) pg8::gemm_phase<pg8::EpiBf16<0>, pg8::StaticOrder, true, true>(F.lds, g, S, E, F.tid);
#endif

            GSEAM(pb + 6);
        }
        if (IN(pb + 7)) {
            RETID();
            const float* modN = MODV + (size_t)(L + 1) * 4 * 12288;
            const bool nx = L + 1 < NLAYER, kv = (L == 1);
#if PHSEL(1)
            if (nx) norm_phase<true, true>(F, XB, Yb, modL + 5 * D_, NORMG + (size_t)(L * 4 + 3) * D_, XB,
                       NORMG + (size_t)((L + 1) * 4 + 0) * D_, modN + 0 * D_, modN + 1 * D_, Hb,
                       kv ? args.in[I_KVNG] : nullptr, kv ? KVMOD : nullptr, kv ? KVMOD + D_ : nullptr, kv ? HKb : nullptr);
            else norm_phase<true, false>(F, XB, Yb, modL + 5 * D_, NORMG + (size_t)(L * 4 + 3) * D_, args.out, nullptr, nullptr, nullptr, nullptr, nullptr, nullptr, nullptr, nullptr);
#endif

            GSEAM(pb + 7);
        }
    }
#undef IN
#undef SEAM
#undef GSEAM
}


#ifndef DBG_TAP
#define DBG_TAP 0
#endif
#if DBG_TAP
__global__ void dbg_tap(Args a, int tap) {
    unsigned char* ws = a.ws; const size_t n = (size_t)M_ * D_;
    const bf16* Hb = (const bf16*)(ws + WS_H); const bf16* Qb = (const bf16*)(ws + WS_Q); const bf16* KV6 = (const bf16*)(ws + WS_KV6); const bf16* Ob = (const bf16*)(ws + WS_O);
    const float* GATES = (const float*)(ws + WS_GATES); const bf16* KCMP = (const bf16*)(ws + WS_KCMP); const float* MODV = (const float*)(ws + WS_MODV);
    const bf16* WFIN = (const bf16*)(ws + WS_WFIN); const bf16* WAIN = (const bf16*)(ws + WS_WAIN); const float* ROPE = (const float*)(ws + WS_ROPE); const float* Yb = (const float*)(ws + WS_Y);
    const bf16* ACTb = (const bf16*)(ws + WS_ACT); const bf16* KSH = (const bf16*)(ws + WS_KSH); const bf16* VSH = (const bf16*)(ws + WS_VSH);
    for (size_t i = (size_t)blockIdx.x * blockDim.x + threadIdx.x; i < n; i += (size_t)gridDim.x * blockDim.x) {
        float v = 0.f;
        if (tap & 1) v += MODV[i % (16 * 12288 + 4 * 4096 + 1024)] + bf2f(WFIN[i]) + bf2f(WAIN[i % ((size_t)NINP * D_)]) + ROPE[i % (S_ * 128)];
        if (tap & 2) v += bf2f(Hb[i]);
        if (tap & 4) v += bf2f(Qb[i]) + bf2f(KV6[i % ((size_t)6 * M_ * 512)]) + bf2f(KV6[(i + (size_t)3 * M_ * 512) % ((size_t)6 * M_ * 512)]) + GATES[i % ((size_t)M_ * 48)];
        if (tap & 8) v += bf2f(KCMP[i % ((size_t)2 * 16 * NCP * HD)]);
        if (tap & 512) { const bf16* W = (const bf16*)(ws + WS_WC1); v += bf2f(W[i % ((size_t)4 * 256 * 4096 + 4 * 128 * 256)]); }
        if (tap & 1024) { const bf16* W = (const bf16*)(ws + WS_WAOUT); v += bf2f(W[i]) + bf2f(W[i + n]) + bf2f(W[(i + 2 * n) % ((WS_WC1 - WS_WAOUT) / 2)]) + bf2f(W[(i + 3 * n) % ((WS_WC1 - WS_WAOUT) / 2)]) + bf2f(W[(i + 4 * n) % ((WS_WC1 - WS_WAOUT) / 2)]) + bf2f(W[(i + 5 * n) % ((WS_WC1 - WS_WAOUT) / 2)]); }
        if (tap & 2048) v += ((const float*)(ws + WS_ACT))[i % ((size_t)256 * 32 * 256)];
        if (tap & 16) v += bf2f(Ob[i]);
        if (tap & 32) v += Yb[i];
        if (tap & 64) v += a.out[i];
        if (tap & 128) v += bf2f(ACTb[i]) + bf2f(ACTb[i + n]);
        if (tap & 256) v += bf2f(KSH[i]) + bf2f(VSH[i]);
        if (tap & 4096) v = (v != v) ? 5000.f : ((fabsf(v) > 100.f) ? 3000.f : v);
        a.out[i] = v;
    }
}
#endif
extern "C" void kernel_launch(void* const* d_in, const int* in_sizes, int n_in, void* d_out, int out_size, void* d_ws, size_t ws_size, hipStream_t stream) {
    static int grid = 0;
    if (grid == 0) {
        if (n_in != 19 || in_sizes[0] != M_ * D_ || out_size != M_ * D_ || ws_size < WS_END) {
            fprintf(stderr, "kernel_launch: unexpected shapes: n_in %d in0 %d out %d ws %zu (need %zu); nothing launched\n", n_in, n_in > 0 ? in_sizes[0] : -1, out_size, ws_size, (size_t)WS_END); grid = -1; return; }
        int dev = 0, cus = 0, per_cu = 0;
        if (hipGetDevice(&dev) != hipSuccess || hipDeviceGetAttribute(&cus, hipDeviceAttributeMultiprocessorCount, dev) != hipSuccess) { grid = -1; return; }
        if (hipFuncSetAttribute((const void*)yoco_fwd, hipFuncAttributeMaxDynamicSharedMemorySize, LDS_BYTES) != hipSuccess) { fprintf(stderr, "kernel_launch: hipFuncSetAttribute failed\n"); grid = -1; return; }
        if (hipOccupancyMaxActiveBlocksPerMultiprocessor(&per_cu, (const void*)yoco_fwd, NTHR, LDS_BYTES) != hipSuccess || per_cu < 1)
            fprintf(stderr, "kernel_launch: note: occupancy query reports %d workgroups per CU\n", per_cu);
        (void)hipGetLastError();
        grid = cus > 256 ? 256 : cus;
    }
    if (grid < 0) return;
    if (hipMemsetAsync((char*)d_ws + WS_CTL, 0, CTL_ZERO_BYTES, stream) != hipSuccess) return;
    Args a{};
    for (int i = 0; i < 19; ++i) a.in[i] = (const float*)d_in[i];
    a.out = (float*)d_out; a.ws = (unsigned char*)d_ws; a.dbg = 0; a.pad = 0;
    for (int j = 0; j < 64; ++j) a.inv[j] = powf(10000.0f, -(float)j / 64.0f);
#if MK_MULTI
#ifndef DBG_STOP
#define DBG_STOP NPHASE
#endif
    for (int ph = 0; ph < DBG_STOP; ++ph) {
        if (ph >= 2 && ((ph - 2) & 7) == 1 && (ph - 2) / 8 >= 2) continue;
        a.ph_lo = ph; a.ph_hi = ph + 1;
        hipLaunchKernelGGL(yoco_fwd, dim3(grid), dim3(NTHR), LDS_BYTES, stream, a);
    }
#if DBG_TAP
    hipLaunchKernelGGL(dbg_tap, dim3(2048), dim3(256), 0, stream, a, (int)DBG_TAP);
#endif
#else
    a.ph_lo = 0; a.ph_hi = NPHASE;
    hipLaunchKernelGGL(yoco_fwd, dim3(grid), dim3(NTHR), LDS_BYTES, stream, a);
#endif
}
```

```cpp
#include <hip/hip_runtime.h>
#include <cstdio>
#include <cstdint>
#include <type_traits>
namespace pg8 {
#define PG8_LAS __attribute__((address_space(3)))
typedef unsigned short bf16_t;
typedef short bf16x8 __attribute__((ext_vector_type(8)));
typedef float f32x4 __attribute__((ext_vector_type(4)));
typedef unsigned u32x4 __attribute__((ext_vector_type(4)));
constexpr int BM = 256, BK = 64, HALF = 128, HTB = HALF * BK * 2  , STAGE_BYTES = 8 * HTB, NXCD = 8, WGM = 8;

__host__ __device__ __forceinline__ int lds_byte(int r, int c) { const int st = (r >> 4) * 2 + (c >> 5), rr = r & 15, cc = c & 31, ob = rr * 64 + cc * 2; return st * 1024 + (ob ^ (((ob >> 9) & 1) << 5)); }
__host__ __device__ __forceinline__ void stage_rc(int b, int& R, int& C) { const int st = b / 1024, sb = b % 1024, swz = sb ^ (((sb >> 9) & 1) << 5); R = (st >> 1) * 16 + swz / 64; C = (st & 1) * 32 + (swz % 64) / 2; }
__host__ __device__ __forceinline__ int perm32(int rho) { const int n = rho >> 4, i = rho & 15; return 8 * (i >> 2) + 4 * n + (i & 3); }

struct Unit { int pm, pn; };
struct Gemm { const bf16_t* A; const bf16_t* Bt; int M, N, K; };

struct StaticOrder {
    int nM, nN, nwg, G, c;
    __host__ __device__ void init(int M, int N, int G_, int c_) { nM = M / BM; nN = N / BM; nwg = nM * nN; G = G_; c = c_; }
    __host__ __device__ bool next(int i, Unit& u) const {
        const long L = (long)i * G + c; if (L >= nwg) return false;
        int wgid = (int)L; { const int q = nwg / NXCD, r = nwg % NXCD, xcd = wgid % NXCD, off = wgid / NXCD; wgid = (xcd < r ? xcd * (q + 1) : r * (q + 1) + (xcd - r) * q) + off; }
        const int nig = WGM * nN, gid = wgid / nig, fm = gid * WGM, gsz = (nM - fm) < WGM ? (nM - fm) : WGM;
        u.pm = fm + ((wgid % nig) % gsz); u.pn = (wgid % nig) / gsz; return true;
    }
    __device__ __forceinline__ void a_ready(const Unit&) const {}
    __device__ __forceinline__ void done(const Unit&) const {}
};
typedef __bf16 bf16x2_t __attribute__((ext_vector_type(2)));
typedef float f32x2_t __attribute__((ext_vector_type(2)));
__device__ __forceinline__ unsigned cvt_pk_bf16(float lo, float hi) { f32x2_t v = {lo, hi}; bf16x2_t b = __builtin_convertvector(v, bf16x2_t); return __builtin_bit_cast(unsigned, b); }
typedef float f32x2 __attribute__((ext_vector_type(2)));
__device__ __forceinline__ f32x2 gelu_pk(f32x2 v) {
    const f32x2 av = __builtin_elementwise_abs(v), d = av * 0.2316418882f + 1.0f;
    f32x2 t; t.x = __builtin_amdgcn_rcpf(d.x); t.y = __builtin_amdgcn_rcpf(d.y);
    f32x2 q = t * 0.5307027145f + (-0.7265760135f); q = q * t + 0.7107068705f; q = q * t + (-0.142248368f); q = q * t + 0.127414796f; q = q * t;
    const f32x2 s = (v * v) * (-0.72134752044f);
    f32x2 e; e.x = __builtin_amdgcn_exp2f(s.x); e.y = __builtin_amdgcn_exp2f(s.y);
    const f32x2 m = v * (q * e), r = v - m;
    f32x2 o; o.x = v.x < 0.f ? m.x : r.x; o.y = v.y < 0.f ? m.y : r.y; return o;
}

template <int ACT  > struct EpiBf16 {
    static constexpr bool PERM = true, AFTER_DRAIN = false; static_assert(ACT == 0 || ACT == 1, "EpiBf16: ACT is 0 (none) or 1 (gelu_pk)");
    static constexpr int S_MIN = 16;
    bf16_t* O; int ldc; const float* bias; int split_cols; size_t split_stride; float scale0;
    __device__ __forceinline__ void operator()(const f32x4 (&acc)[2][2][4][2], const Unit& u, int wr, int wc, int fr, int fq) const {
        const int row0 = u.pm * BM + wr * 64 + fr; int colt = u.pn * BM; bf16_t* base = O;
        float sc = 1.f; if (split_cols) { const int t = colt / split_cols; base += (size_t)t * split_stride; colt -= t * split_cols; if (t == 0) sc = scale0; }
        const int col0 = colt + wc * 32 + 8 * fq, bcol0 = u.pn * BM + wc * 32 + 8 * fq;
        f32x4 bv[2][2];
#pragma unroll
        for (int bj = 0; bj < 2; ++bj)
#pragma unroll
            for (int n = 0; n < 2; ++n) bv[bj][n] = bias ? *(const f32x4*)(bias + bcol0 + bj * HALF + 4 * n) : (f32x4){0.f, 0.f, 0.f, 0.f};
#pragma unroll
        for (int ai = 0; ai < 2; ++ai)
#pragma unroll
            for (int m = 0; m < 4; ++m) { bf16_t* rowp = base + (size_t)(row0 + ai * HALF + m * 16) * ldc + col0;
#pragma unroll
                for (int bj = 0; bj < 2; ++bj) { f32x4 v0 = acc[ai][bj][m][0] + bv[bj][0], v1 = acc[ai][bj][m][1] + bv[bj][1];
                    if (ACT == 1) { f32x2 a = gelu_pk((f32x2){v0[0], v0[1]}), b = gelu_pk((f32x2){v0[2], v0[3]}), c = gelu_pk((f32x2){v1[0], v1[1]}), d = gelu_pk((f32x2){v1[2], v1[3]});
                        v0 = (f32x4){a.x, a.y, b.x, b.y}; v1 = (f32x4){c.x, c.y, d.x, d.y}; }
                    v0 = v0 * sc; v1 = v1 * sc; u32x4 w; w.x = cvt_pk_bf16(v0[0], v0[1]); w.y = cvt_pk_bf16(v0[2], v0[3]); w.z = cvt_pk_bf16(v1[0], v1[1]); w.w = cvt_pk_bf16(v1[2], v1[3]);
                    *(u32x4*)(rowp + bj * HALF) = w; } }
    }
};
struct EpiF32 {
    static constexpr bool PERM = false, AFTER_DRAIN = false;
    static constexpr int S_MIN = 16;
    float* C; int ldc;
    __device__ __forceinline__ void operator()(const f32x4 (&acc)[2][2][4][2], const Unit& u, int wr, int wc, int fr, int fq) const {
        const int row0 = u.pm * BM + wr * 64 + fr, col0 = u.pn * BM + wc * 32 + 4 * fq;
#pragma unroll
        for (int ai = 0; ai < 2; ++ai)
#pragma unroll
            for (int m = 0; m < 4; ++m) { float* rowp = C + (size_t)(row0 + ai * HALF + m * 16) * ldc + col0;
#pragma unroll
                for (int bj = 0; bj < 2; ++bj)
#pragma unroll
                    for (int n = 0; n < 2; ++n) *(f32x4*)(rowp + bj * HALF + n * 16) = acc[ai][bj][m][n]; }
    }
};
typedef unsigned u32x2 __attribute__((ext_vector_type(2)));
struct EpiNsaProj {
    static constexpr bool PERM = true, AFTER_DRAIN = false;
    static constexpr int S_MIN = 16;
    bf16_t* Q; bf16_t* KV6; const float* rope;
    __device__ __forceinline__ void operator()(const f32x4 (&acc)[2][2][4][2], const Unit& u, int wr, int wc, int fr, int fq) const {
        const int row0 = u.pm * BM + wr * 64 + fr, j = wc * 4 + fq;
        const int seg0 = u.pn * 2;
        bf16_t* dst; int ld; bool do_rope;
        if (seg0 < 16) { dst = Q + seg0 * 128; ld = 2048; do_rope = true; }
        else { const int s6 = (seg0 - 16) >> 2, gg = (seg0 - 16) & 3; dst = KV6 + (size_t)s6 * ((size_t)16384 * 512) + gg * 128; ld = 512; do_rope = (s6 == 0) || (s6 == 2) || (s6 == 4); }
#pragma unroll
        for (int ai = 0; ai < 2; ++ai)
#pragma unroll
            for (int mp = 0; mp < 2; ++mp) {
                f32x4 cs[2], sn[2];
                if (do_rope) {
#pragma unroll
                    for (int e = 0; e < 2; ++e) { const int row = row0 + ai * HALF + (2 * mp + e) * 16; const float* rp = rope + ((size_t)(row & 4095) * 64 + 4 * j) * 2;
                        const f32x4 c01 = *(const f32x4*)rp, c23 = *(const f32x4*)(rp + 4);
                        cs[e] = (f32x4){c01[0], c01[2], c23[0], c23[2]}; sn[e] = (f32x4){c01[1], c01[3], c23[1], c23[3]}; }
                }
#pragma unroll
                for (int bj = 0; bj < 2; ++bj) {
                    u32x2 w1[2], w2[2];
#pragma unroll
                    for (int e = 0; e < 2; ++e) { const int m = 2 * mp + e;
                        f32x4 x1 = acc[ai][bj][m][0], x2 = acc[ai][bj][m][1];
                        if (do_rope) { const f32x4 o1 = x1 * cs[e] - x2 * sn[e], o2 = x2 * cs[e] + x1 * sn[e]; x1 = o1; x2 = o2; }
                        w1[e].x = cvt_pk_bf16(x1[0], x1[1]); w1[e].y = cvt_pk_bf16(x1[2], x1[3]); w2[e].x = cvt_pk_bf16(x2[0], x2[1]); w2[e].y = cvt_pk_bf16(x2[2], x2[3]); }
                    const auto ax = __builtin_amdgcn_permlane16_swap(w1[0].x, w1[1].x, false, false), ay = __builtin_amdgcn_permlane16_swap(w1[0].y, w1[1].y, false, false);
                    const auto bx = __builtin_amdgcn_permlane16_swap(w2[0].x, w2[1].x, false, false), by = __builtin_amdgcn_permlane16_swap(w2[0].y, w2[1].y, false, false);
                    u32x4 o1, o2; o1.x = ax[0]; o1.y = ay[0]; o1.z = ax[1]; o1.w = ay[1]; o2.x = bx[0]; o2.y = by[0]; o2.z = bx[1]; o2.w = by[1];
                    bf16_t* rp2 = dst + bj * 128 + (size_t)(row0 + ai * HALF + (2 * mp + (fq & 1)) * 16) * ld + 4 * (j & ~1);
                    *(u32x4*)rp2 = o1; *(u32x4*)(rp2 + 64) = o2; }
            }
    }
};
struct EpiSwiglu {
    static constexpr bool PERM = true, AFTER_DRAIN = false;
    static constexpr int S_MIN = 8;
    bf16_t* O; int ldc;
    __device__ __forceinline__ u32x2 act4(const f32x4& g, const f32x4& up) const { f32x4 r;
#pragma unroll
        for (int i = 0; i < 4; ++i) r[i] = g[i] * __builtin_amdgcn_rcpf(1.0f + __builtin_amdgcn_exp2f(g[i])) * up[i];
        u32x2 w; w.x = cvt_pk_bf16(r[0], r[1]); w.y = cvt_pk_bf16(r[2], r[3]); return w; }
    __device__ __forceinline__ void operator()(const f32x4 (&acc)[2][2][4][2], const Unit& u, int wr, int wc, int fr, int fq) const {
        const int row0 = u.pm * BM + wr * 64 + fr + (fq & 1) * 16, col0 = (u.pn * BM + wc * 32 + 8 * (fq & ~1)) >> 1;
#pragma unroll
        for (int ai = 0; ai < 2; ++ai)
#pragma unroll
            for (int mp = 0; mp < 2; ++mp) { bf16_t* rowp = O + (size_t)(row0 + ai * HALF + mp * 32) * ldc + col0;
#pragma unroll
                for (int bj = 0; bj < 2; ++bj) { const u32x2 wa = act4(acc[ai][bj][2 * mp][0], acc[ai][bj][2 * mp][1]), wb = act4(acc[ai][bj][2 * mp + 1][0], acc[ai][bj][2 * mp + 1][1]);
                    const auto sx = __builtin_amdgcn_permlane16_swap(wa.x, wb.x, false, false), sy = __builtin_amdgcn_permlane16_swap(wa.y, wb.y, false, false);
                    u32x4 w; w.x = sx[0]; w.y = sy[0]; w.z = sx[1]; w.w = sy[1];
                    *(u32x4*)(rowp + bj * (HALF / 2)) = w; } }
    }
};
template <class Epi, class Sched, bool ALIGN_EPI = false, bool SP2 = false>
__device__ __forceinline__ void gemm_phase(PG8_LAS unsigned char* lds, const Gemm g, const Sched& S, const Epi& E, int tid_in) {
    int tid_ = tid_in; asm volatile("" : "+v"(tid_));
    const int tid = tid_, wid = __builtin_amdgcn_readfirstlane(tid >> 6), lane = tid & 63, wr = wid >> 2, wc = wid & 3, fr = lane & 15, fq = lane >> 4;
    const int K = g.K, nt = K / BK;
    unsigned voffA[2], voffB[2];
#pragma unroll
    for (int i = 0; i < 2; ++i) { int R, C; stage_rc(tid * 16 + i * 8192, R, C); const int Rb = Epi::PERM ? ((R & ~31) + perm32(R & 31)) : R;
        voffA[i] = (unsigned)(R * K + C) * 2u; voffB[i] = (unsigned)(Rb * K + C) * 2u; }
    const size_t kstep = (size_t)(BK * 2);
    const size_t hstep = (size_t)HALF * K * 2;
    const size_t tstep = 2 * hstep;
    const unsigned ldsw = (unsigned)wid * 1024u;
    const int aoff = lds_byte(wr * 64 + fr, fq * 8), boff = lds_byte(wc * 32 + fr, fq * 8);
#define PG8_SA(b, h) (((b) * 2 + (h)) * HTB)
#define PG8_SB(b, h) ((4 + (b) * 2 + (h)) * HTB)
#define PG8_STAGE(bufoff, gbase, voff) do { _Pragma("unroll") for (int _i = 0; _i < 2; ++_i) \
        __builtin_amdgcn_global_load_lds((const unsigned*)((const char*)(gbase) + (voff)[_i]), (PG8_LAS unsigned*)(lds + (bufoff) + ldsw + _i * 8192), 16, 0, 0); } while (0)
#define PG8_LDA(dst, b, h) do { _Pragma("unroll") for (int m = 0; m < 4; ++m) _Pragma("unroll") for (int k = 0; k < 2; ++k) dst[m][k] = *(const PG8_LAS bf16x8*)(lds + PG8_SA(b, h) + aoff + m * 2048 + k * 1024); } while (0)
#define PG8_LDB(dst, b, h) do { _Pragma("unroll") for (int n = 0; n < 2; ++n) _Pragma("unroll") for (int k = 0; k < 2; ++k) dst[n][k] = *(const PG8_LAS bf16x8*)(lds + PG8_SB(b, h) + boff + n * 2048 + k * 1024); } while (0)
#define PG8_MMA(ai, bj, At, Bt) do { __builtin_amdgcn_s_setprio(1); _Pragma("unroll") for (int m = 0; m < 4; ++m) _Pragma("unroll") for (int n = 0; n < 2; ++n) _Pragma("unroll") for (int k = 0; k < 2; ++k) \
        acc[ai][bj][m][n] = __builtin_amdgcn_mfma_f32_16x16x32_bf16(Bt[n][k], At[m][k], acc[ai][bj][m][n], 0, 0, 0); __builtin_amdgcn_s_setprio(0); } while (0)
#define PG8_WAIT_V(n) asm volatile("s_waitcnt vmcnt(" #n ")" ::: "memory")
#define PG8_WAIT_L(n) asm volatile("s_waitcnt lgkmcnt(" #n ")" ::: "memory")
#define PG8_BAR __builtin_amdgcn_s_barrier()
#define PG8_SCHED __builtin_amdgcn_sched_barrier(0)
    static_assert(ALIGN_EPI && SP2, "this copy keeps only the two-super-phase loop with aligned epilogues");
    Unit cur, nxt; int ui = 0;
    if (!S.next(0, cur)) return;
    f32x4 acc[2][2][4][2];
#pragma unroll
    for (int a = 0; a < 2; ++a)
#pragma unroll
        for (int b = 0; b < 2; ++b)
#pragma unroll
            for (int m = 0; m < 4; ++m)
#pragma unroll
                for (int n = 0; n < 2; ++n) { acc[a][b][m][n] = (f32x4){0.f, 0.f, 0.f, 0.f}; asm volatile("" : "+v"(acc[a][b][m][n])); }
    bf16x8 At[4][2], B0[2][2], B1[2][2];
    const char* cA = (const char*)g.A + (size_t)cur.pm * tstep; const char* cB = (const char*)g.Bt + (size_t)cur.pn * tstep;
    const char* nA = cA; const char* nB = cB; bool has_next = false;
    S.a_ready(cur);
    PG8_STAGE(PG8_SB(0, 0), cB, voffB); PG8_STAGE(PG8_SB(0, 1), cB + hstep, voffB); PG8_STAGE(PG8_SA(0, 0), cA, voffA); PG8_STAGE(PG8_SA(0, 1), cA + hstep, voffA);
    PG8_STAGE(PG8_SB(1, 0), cB + kstep, voffB); PG8_STAGE(PG8_SA(1, 0), cA + kstep, voffA); PG8_STAGE(PG8_SB(1, 1), cB + hstep + kstep, voffB); PG8_STAGE(PG8_SA(1, 1), cA + hstep + kstep, voffA);
    if (wr == 1) PG8_BAR;
    PG8_WAIT_V(0); PG8_BAR; PG8_BAR;
    constexpr int W0 = 10 + Epi::S_MIN;
    auto ktiles = [&](const int t, const int nt_, const int first) __attribute__((always_inline)) {
        const bool last = (t == nt_ - 2);
        const char* a1 = cA + (size_t)(t + 1) * kstep;
        const char* a2 = last ? nA : cA + (size_t)(t + 2) * kstep; const char* b2 = last ? nB : cB + (size_t)(t + 2) * kstep;
        const char* a3 = a2 + kstep; const char* b3 = b2 + kstep;
        if (last && has_next) S.a_ready(nxt);
        PG8_LDB(B0, 0, 0); PG8_LDB(B1, 0, 1); PG8_SCHED; PG8_LDA(At, 0, 0); PG8_STAGE(PG8_SA(1, 1), a1 + hstep, voffA);
        if (first) asm volatile("s_waitcnt vmcnt(%0)" :: "n"(W0) : "memory"); else PG8_WAIT_V(8); PG8_WAIT_L(0); PG8_BAR; PG8_MMA(0, 0, At, B0); PG8_MMA(0, 1, At, B1); PG8_BAR; PG8_SCHED;
        PG8_LDA(At, 0, 1); PG8_STAGE(PG8_SB(0, 0), b2, voffB); PG8_STAGE(PG8_SB(0, 1), b2 + hstep, voffB); PG8_STAGE(PG8_SA(0, 0), a2, voffA);
        if (first) asm volatile("s_waitcnt vmcnt(%0)" :: "n"(W0) : "memory"); else PG8_WAIT_V(8); PG8_WAIT_L(0); PG8_BAR; PG8_MMA(1, 0, At, B0); PG8_MMA(1, 1, At, B1); PG8_BAR; PG8_SCHED;
        PG8_LDB(B0, 1, 0); PG8_LDB(B1, 1, 1); PG8_SCHED; PG8_LDA(At, 1, 0); PG8_STAGE(PG8_SA(0, 1), a2 + hstep, voffA);
        if (first) asm volatile("s_waitcnt vmcnt(%0)" :: "n"(W0) : "memory"); else PG8_WAIT_V(8); PG8_WAIT_L(0); PG8_BAR; PG8_MMA(0, 0, At, B0); PG8_MMA(0, 1, At, B1); PG8_BAR; PG8_SCHED;
        PG8_LDA(At, 1, 1); PG8_STAGE(PG8_SB(1, 0), b3, voffB); PG8_STAGE(PG8_SB(1, 1), b3 + hstep, voffB); PG8_STAGE(PG8_SA(1, 0), a3, voffA);
        PG8_WAIT_V(8); PG8_WAIT_L(0); PG8_BAR; PG8_MMA(1, 0, At, B0); PG8_MMA(1, 1, At, B1); PG8_BAR; PG8_SCHED;
    };
    for (;;) {
        has_next = S.next(ui + 1, nxt);
        nA = has_next ? (const char*)g.A + (size_t)nxt.pm * tstep : cA; nB = has_next ? (const char*)g.Bt + (size_t)nxt.pn * tstep : cB;
        int sm = 1; asm volatile("" : "+s"(sm));
#pragma nounroll
        for (int t = 0; t < nt; t += 2) { ktiles(t, nt, sm); sm = 0; asm volatile("" : "+s"(sm)); }
        if (wr == 0) PG8_BAR;
        if (has_next) PG8_STAGE(PG8_SA(1, 1), nA + kstep + hstep, voffA);
        if constexpr (!Epi::AFTER_DRAIN) { E(acc, cur, wr, wc, fr, fq); S.done(cur); }
        if (!has_next) break;
#pragma unroll
        for (int a = 0; a < 2; ++a)
#pragma unroll
            for (int b = 0; b < 2; ++b)
#pragma unroll
                for (int m = 0; m < 4; ++m)
#pragma unroll
                    for (int n = 0; n < 2; ++n) { acc[a][b][m][n] = (f32x4){0.f, 0.f, 0.f, 0.f}; asm volatile("" : "+v"(acc[a][b][m][n])); }
        cur = nxt; cA = nA; cB = nB; ++ui;
        if (wr == 1) PG8_BAR;
    }
    PG8_WAIT_V(0);
    PG8_BAR;
    if constexpr (Epi::AFTER_DRAIN) { E.fused(acc, cur, wr, wc, fr, fq, lds, wid, lane); S.done(cur); }
#undef PG8_SA
#undef PG8_SB
#undef PG8_STAGE
#undef PG8_LDA
#undef PG8_LDB
#undef PG8_MMA
#undef PG8_WAIT_V
#undef PG8_WAIT_L
#undef PG8_BAR
#undef PG8_SCHED
}
}

constexpr int NB_ = 4, S_ = 4096, D_ = 2048, M_ = NB_ * S_, NH = 16, HD = 128, NG = 4, DFF = 5632, NIN = 5168, NINP = 5376, NPROJ = 5120  , NLAYER = 4;
constexpr int NCP = 256;
constexpr float EPS = 1e-6f;
constexpr float SCALE = 0.08838834764831845f;
constexpr float C2 = SCALE * 1.4426950408889634f;
constexpr int NWAVES = 8, NTHR = 512;

constexpr size_t MiB = 1u << 20;
constexpr size_t WS_CTL = 0, CTL_ZERO_BYTES = 1 * MiB;
constexpr size_t WS_MODV = 1 * MiB;
constexpr size_t WS_KVMOD = WS_MODV + (size_t)4 * 4 * 12288 * 4;
constexpr size_t WS_PEB = WS_KVMOD + (size_t)4 * 4096 * 4;
constexpr size_t WS_ROPE = 2 * MiB;
constexpr size_t WS_WAIN = 4 * MiB;
constexpr size_t SZ_WAIN = (size_t)NINP * D_ * 2;
constexpr size_t WS_WAOUT = WS_WAIN + 2 * SZ_WAIN;
constexpr size_t SZ_WSQ = (size_t)D_ * D_ * 2;
constexpr size_t WS_WBQ = WS_WAOUT + 2 * SZ_WSQ;
constexpr size_t WS_WBOUT = WS_WBQ + 2 * SZ_WSQ;
constexpr size_t WS_WKV = WS_WBOUT + 2 * SZ_WSQ;
constexpr size_t WS_WFIN = WS_WKV + 2 * SZ_WSQ;
constexpr size_t SZ_WFIN = (size_t)2 * DFF * D_ * 2;
constexpr size_t WS_WFOUT = WS_WFIN + 4 * SZ_WFIN;
constexpr size_t SZ_WFOUT = (size_t)D_ * DFF * 2;
constexpr size_t WS_WC1 = WS_WFOUT + 4 * SZ_WFOUT;
constexpr size_t SZ_WC1 = (size_t)256 * 4096 * 2;
constexpr size_t WS_WC2 = WS_WC1 + 4 * SZ_WC1;
constexpr size_t SZ_WC2 = (size_t)128 * 256 * 2;
constexpr size_t WS_WG = WS_WC2 + 4 * SZ_WC2;
constexpr size_t SZ_WG = (size_t)64 * D_ * 2;
constexpr size_t WS_ACT0 = (WS_WG + 2 * SZ_WG + MiB - 1) / MiB * MiB;
constexpr size_t SZ_MD2 = (size_t)M_ * D_ * 2;
constexpr size_t WS_H = WS_ACT0;
constexpr size_t WS_HK = WS_H + SZ_MD2;
constexpr size_t WS_Q = WS_HK + SZ_MD2;
constexpr size_t WS_KV6 = WS_Q + SZ_MD2;
constexpr size_t WS_GATES = WS_KV6 + (size_t)6 * M_ * 512 * 2;
constexpr size_t WS_KCMP = WS_GATES + (size_t)M_ * 48 * 4;
constexpr size_t WS_O = WS_KCMP + (size_t)2 * 16 * NCP * HD * 2;
constexpr size_t WS_Y = WS_O + SZ_MD2;
constexpr size_t WS_ACT = WS_Y + 2 * SZ_MD2;
constexpr size_t WS_KSH = WS_ACT + (size_t)M_ * DFF * 2;
constexpr size_t WS_VSH = WS_KSH + SZ_MD2;
constexpr size_t WS_STASH = WS_VSH + SZ_MD2;
constexpr size_t WS_XB = WS_STASH + (size_t)256 * 32768 * 4;
constexpr size_t WS_END = WS_XB + SZ_MD2;
constexpr int CW_BAR = 4096;
constexpr int CW_DBG = 16384;

constexpr int RING_BYTES = 131072;
constexpr int LDS_BYTES = 147456;
constexpr int LDSCTL_OFF = LDS_BYTES - 1024, MISC_OFF = LDSCTL_OFF + 320;

#define GAS __attribute__((address_space(1)))
#define LAS __attribute__((address_space(3)))
typedef unsigned short bf16;
typedef unsigned u32x4 __attribute__((ext_vector_type(4)));
typedef unsigned u32x2 __attribute__((ext_vector_type(2)));
typedef float f32x4 __attribute__((ext_vector_type(4)));
typedef float f32x2 __attribute__((ext_vector_type(2)));
typedef float f32x16 __attribute__((ext_vector_type(16)));
typedef short bf16x8 __attribute__((ext_vector_type(8)));
typedef short s16x4 __attribute__((ext_vector_type(4)));
#define LDS_WAIT() asm volatile("s_waitcnt lgkmcnt(0)" ::: "memory")
#define VM_WAIT() asm volatile("s_waitcnt vmcnt(0)" ::: "memory")
#define SBAR() __builtin_amdgcn_sched_barrier(0)
__device__ __forceinline__ unsigned cvtpk(float lo, float hi) { return pg8::cvt_pk_bf16(lo, hi); }
__device__ __forceinline__ float bf2f(bf16 v) { return __uint_as_float(((unsigned)v) << 16); }
__device__ __forceinline__ float lx1(float v) { return __int_as_float(__builtin_amdgcn_mov_dpp(__float_as_int(v), 0xB1, 0xF, 0xF, true)); }
__device__ __forceinline__ float lx2(float v) { return __int_as_float(__builtin_amdgcn_mov_dpp(__float_as_int(v), 0x4E, 0xF, 0xF, true)); }
template <int X> __device__ __forceinline__ float lswz(float v) { return __int_as_float(__builtin_amdgcn_ds_swizzle(__float_as_int(v), 0x1F | (X << 10))); }
__device__ __forceinline__ float wave_sum(float v) {
    v += lx1(v); v += lx2(v); v += lswz<4>(v); v += lswz<8>(v); v += lswz<16>(v);
    auto rr = __builtin_amdgcn_permlane32_swap(__float_as_uint(v), __float_as_uint(v), false, false);
    return __uint_as_float(rr[0]) + __uint_as_float(rr[1]);
}

#define XB_TMO      128
#define XB_XCNT(j)  (256  + 64 * (j))
#define XB_XSUB(j)  (1280 + 64 * (j))
#define XB_XGEN(j)  (2304 + 64 * (j))
#define XB_TOP      3328
#define XB_TOPGEN   3392
#define XB_GCNT(j)  (3456 + 64 * (j))
#define XB_XID      4096
#define XCD_BAR_WORDS 3456
#define XB_SPIN_CAP (1u << 18)
__device__ __forceinline__ unsigned xb_ld(unsigned* p)              { return __hip_atomic_load(p, __ATOMIC_RELAXED, __HIP_MEMORY_SCOPE_AGENT); }
__device__ __forceinline__ unsigned xb_add(unsigned* p, unsigned v) { return __hip_atomic_fetch_add(p, v, __ATOMIC_RELAXED, __HIP_MEMORY_SCOPE_AGENT); }
__device__ __forceinline__ unsigned xb_xcc_id() { return (unsigned)__builtin_amdgcn_s_getreg((3 << 11) | 20) & 0xFu; }
#define XB_SPIN(cond, bar) do { unsigned _sp = 0; while (cond) { __builtin_amdgcn_s_sleep(1); \
    if ((++_sp & 255u) == 0u) { if (xb_ld(&(bar)[XB_TMO])) break; if (_sp > XB_SPIN_CAP) { atomicAdd(&(bar)[XB_TMO], 1u); break; } } } } while (0)
struct XcdBarrier { unsigned* bar; unsigned x; volatile LAS unsigned* st; };
__device__ __forceinline__ XcdBarrier xcd_barrier_post(unsigned* bar, volatile LAS unsigned* st, bool leader  ) {
    XcdBarrier b; b.bar = bar; b.x = xb_xcc_id(); b.st = st;
    if (leader) { (void)xb_add(&bar[XB_XCNT(b.x)], 1u); __hip_atomic_store(&bar[XB_XID + blockIdx.x], b.x + 1u, __ATOMIC_RELAXED, __HIP_MEMORY_SCOPE_AGENT); }
    return b;
}
__device__ __forceinline__ void xcd_barrier_complete(unsigned* bar, unsigned x, unsigned& nloc, unsigned& nx) {
    const unsigned G = gridDim.x * gridDim.y * gridDim.z;
    unsigned sum, cnt, mine, sp = 0u;
    for (;;) {
        sum = 0u; cnt = 0u; mine = 0u;
#pragma unroll
        for (unsigned j = 0; j < 16; ++j) { const unsigned c = xb_ld(&bar[XB_XCNT(j)]); sum += c; cnt += (c > 0u) ? 1u : 0u; mine = (j == x) ? c : mine; }
        if (sum == G) break;
        __builtin_amdgcn_s_sleep(1);
        if ((++sp & 255u) == 0u) { if (xb_ld(&bar[XB_TMO])) break; if (sp > XB_SPIN_CAP) { atomicAdd(&bar[XB_TMO], 1u); break; } }
    }
    nloc = mine > 0u ? mine : 1u; nx = cnt > 0u ? cnt : 1u;
}
__device__ __forceinline__ void xcd_barrier(const XcdBarrier& b, bool leader  ) {
    asm volatile("s_waitcnt vmcnt(0)" ::: "memory");
    __syncthreads();
    if (leader) {
        unsigned* bar = b.bar;
        __builtin_amdgcn_s_waitcnt(0);
        unsigned nloc = b.st[0], nx = b.st[1];
        if (nloc == 0u) { xcd_barrier_complete(bar, b.x, nloc, nx); b.st[0] = nloc; b.st[1] = nx; }
        const unsigned old = xb_add(&bar[XB_XSUB(b.x)], 1u);
        const unsigned gen = old / nloc;
        if (old + 1u == (gen + 1u) * nloc) {
            __builtin_amdgcn_fence(__ATOMIC_RELEASE, "agent");
            asm volatile("s_waitcnt vmcnt(0)" ::: "memory");
            const unsigned og = xb_add(&bar[XB_TOP], 1u);
            const unsigned tg = og / nx;
            if (og + 1u == (tg + 1u) * nx) xb_add(&bar[XB_TOPGEN], 1u);
            else XB_SPIN(xb_ld(&bar[XB_TOPGEN]) == tg, bar);
            __builtin_amdgcn_fence(__ATOMIC_ACQUIRE, "agent");
            xb_add(&bar[XB_XGEN(b.x)], 1u);
            asm volatile("s_waitcnt vmcnt(0)" ::: "memory");
        } else {
            XB_SPIN(xb_ld(&bar[XB_XGEN(b.x)]) == gen, bar);
            __builtin_amdgcn_fence(__ATOMIC_ACQUIRE, "agent");
            asm volatile("s_waitcnt vmcnt(0)" ::: "memory");
        }
    }
    __syncthreads();
}

__device__ __forceinline__ void group_barrier(const XcdBarrier& b, int tid) {
    const bool leader = (tid == 0);
    if (b.st[2] == 0u) {
        if (tid < (int)gridDim.x) { const unsigned a = xb_ld(&b.bar[XB_XID + tid]), f = xb_ld(&b.bar[XB_XID + (tid & 7)]); if (a == 0u || a != f) b.st[3] = 1u; }
        if (tid < 8) { const unsigned a = xb_ld(&b.bar[XB_XID + tid]); for (int u = 0; u < tid; ++u) if (xb_ld(&b.bar[XB_XID + u]) == a) b.st[3] = 1u; }
        __syncthreads();
        if (leader) b.st[2] = (gridDim.x == 256u && b.st[3] == 0u) ? 1u : 2u;
        __syncthreads();
    }
    if (b.st[2] != 1u) { xcd_barrier(b, leader); return; }
    asm volatile("s_waitcnt vmcnt(0)" ::: "memory");
    __syncthreads();
    if (leader) {
        unsigned* bar = b.bar; const unsigned g = blockIdx.x & 7u;
        const unsigned old = xb_add(&bar[XB_GCNT(g)], 1u);
        const unsigned target = (old / 32u + 1u) * 32u;
        XB_SPIN(xb_ld(&bar[XB_GCNT(g)]) < target, bar);
        __builtin_amdgcn_fence(__ATOMIC_ACQUIRE, "agent");
        asm volatile("s_waitcnt vmcnt(0)" ::: "memory");
    }
    __syncthreads();
}

__device__ __forceinline__ int mk_tid(int wave_s) { int l; asm volatile("v_mbcnt_lo_u32_b32 %0, -1, 0\n\tv_mbcnt_hi_u32_b32 %0, -1, %0" : "=v"(l)); return (wave_s << 6) | l; }
struct Args { const float* in[19]; float* out; unsigned char* ws; int ph_lo, ph_hi, dbg, pad; float inv[64]; };
enum { I_X = 0, I_C, I_MODW, I_MODB, I_NORMG, I_FWIN, I_FWOUT, I_AWIN, I_AGATEB, I_APE, I_AW1, I_AW2, I_AWOUT, I_BWQ, I_BWOUT, I_KVNG, I_KVMODW, I_KVMODB, I_KVW };
struct Frame {
    LAS unsigned char* lds;
    int tid, lane, wave, vcu, G;
    unsigned char* ws;
};

template <int MODE> __device__ __forceinline__ int src_col(int c) {
    if (MODE == 0) return c;
    if (MODE == 1) { const int g8 = c >> 3, i = c & 7; return (i < 4) ? g8 * 4 + i : DFF + g8 * 4 + (i - 4); }
    if (MODE == 3) return (c < 48) ? 5120 + c : -1;
    if (c >= NIN) return -1;
    if (c >= 5120) return c;
    const int hb = c & ~127, p = c & 127, jj = p >> 3, i = p & 7;
    return hb + ((i < 4) ? 4 * jj + i : 64 + 4 * jj + (i - 4));
}
template <int MODE, int DST = 0> __device__ __forceinline__ void p0_transpose_item(const float* W, int K, int ld, bf16* WT, LAS float* scr, int item, int nblk, int lane) {
    const int kb = item / nblk, nb = item - kb * nblk, k0 = 64 * kb, n0 = 64 * nb;
    const int c4 = (lane & 15) * 4, sc = src_col<MODE>(n0 + c4), kr = lane >> 4;
    f32x4 v[16];
#pragma unroll
    for (int i = 0; i < 16; ++i) v[i] = (sc >= 0) ? *(const f32x4*)(W + (size_t)(k0 + kr + 4 * i) * ld + sc) : (f32x4){0.f, 0.f, 0.f, 0.f};
    if (MODE == 1) {
        const float f_ = ((n0 + c4) & 4) ? -0.6931471805599453f : -1.4426950408889634f;
#pragma unroll
        for (int i = 0; i < 16; ++i) v[i] *= f_; }
#pragma unroll
    for (int i = 0; i < 16; ++i) { LAS float* s = scr + (kr + 4 * i) * 65 + c4; s[0] = v[i][0]; s[1] = v[i][1]; s[2] = v[i][2]; s[3] = v[i][3]; }
    LDS_WAIT(); asm volatile("" ::: "memory");
#pragma unroll
    for (int t = 0; t < 8; ++t) { const int q = lane + 64 * t, n = q >> 3, c = q & 7; const LAS float* s = scr + (8 * c) * 65 + n;
        u32x4 o; o.x = cvtpk(s[0], s[65]); o.y = cvtpk(s[2 * 65], s[3 * 65]); o.z = cvtpk(s[4 * 65], s[5 * 65]); o.w = cvtpk(s[6 * 65], s[7 * 65]);
        if (DST == 0) *(u32x4*)(WT + (size_t)(n0 + n) * K + k0 + 8 * c) = o;
        else if (DST == 2) { const int nn = n0 + n, kk = k0 + 8 * c;
            *(u32x4*)(WT + ((size_t)(((nn >> 5) * (K >> 6) + (kk >> 6)) * 4 + ((kk >> 3) & 3)) * 64 + ((kk >> 5) & 1) * 32 + (nn & 31)) * 8) = o; }
        else { const int nn = n0 + n, kk = k0 + 8 * c;
            *(u32x4*)(WT + ((size_t)((nn >> 5) * (K >> 4) + (kk >> 4)) * 64 + ((kk >> 3) & 1) * 32 + (nn & 31)) * 8) = o; } }
    LDS_WAIT(); asm volatile("" ::: "memory");
}
template <int NB, int K> __device__ __forceinline__ void gemv_item(const float* W, int ldw, int col0, const LAS float* xs, LAS float* red, const float* bias, float* out, int ostride, Frame& F) {
    constexpr int kper = K / 8; const int kbeg = F.wave * kper;
    f32x4 acc[NB];
#pragma unroll
    for (int b = 0; b < NB; ++b) acc[b] = (f32x4){0.f, 0.f, 0.f, 0.f};
    const float* wp = W + (size_t)kbeg * ldw + col0 + 4 * F.lane;
    for (int k = 0; k < kper; k += 8) {
        f32x4 w[8];
#pragma unroll
        for (int u = 0; u < 8; ++u) w[u] = *(const f32x4*)(wp + (size_t)(k + u) * ldw);
#pragma unroll
        for (int u = 0; u < 8; ++u)
#pragma unroll
            for (int b = 0; b < NB; ++b) { const float x = xs[b * K + kbeg + k + u]; acc[b] += w[u] * x; }
    }
#pragma unroll
    for (int b = 0; b < NB; ++b) *(LAS f32x4*)(red + ((F.wave * NB + b) * 256 + 4 * F.lane)) = acc[b];
    __syncthreads();
    for (int e = F.tid; e < NB * 256; e += NTHR) { const int b = e >> 8, c = e & 255; float s = 0.f;
#pragma unroll
        for (int w = 0; w < 8; ++w) s += red[(w * NB + b) * 256 + c];
        out[(size_t)b * ostride + col0 + c] = s + (bias ? bias[col0 + c] : 0.f); }
    __syncthreads();
}
__device__ __forceinline__ void sincos_acc(float ang, float& c, float& s) {
    const double x = (double)ang;
    const double k = rint(x * 0.63661977236758134308);
    double r = fma(-k, 1.57079632679489655800, x); r = fma(-k, 6.123233995736766e-17, r);
    const int q = ((int)k) & 3;
    const double r2 = r * r;
    const double sp = r * (1.0 + r2 * (-1.0 / 6 + r2 * (1.0 / 120 + r2 * (-1.0 / 5040 + r2 * (1.0 / 362880 + r2 * (-1.0 / 39916800 + r2 * (1.0 / 6227020800.0)))))));
    const double cp = 1.0 + r2 * (-0.5 + r2 * (1.0 / 24 + r2 * (-1.0 / 720 + r2 * (1.0 / 40320 + r2 * (-1.0 / 3628800 + r2 * (1.0 / 479001600.0 + r2 * (-1.0 / 87178291200.0)))))));
    const double sv = (q == 0) ? sp : (q == 1) ? cp : (q == 2) ? -sp : -cp;
    const double cv = (q == 0) ? cp : (q == 1) ? -sp : (q == 2) ? -cp : sp;
    c = (float)cv; s = (float)sv;
}
__device__ __forceinline__ void p0_prologue(Frame& F, const Args& a) {
    unsigned char* ws = F.ws;
    { float* rope = (float*)(ws + WS_ROPE);
      for (int i = blockIdx.x * NTHR + F.tid; i < S_ * 64; i += F.G * NTHR) { const int s = i >> 6, j = i & 63; float c, sn; sincos_acc((float)s * a.inv[j], c, sn); rope[2 * i] = c; rope[2 * i + 1] = sn; } }
    { LAS float* xs = (LAS float*)F.lds; LAS float* red = (LAS float*)(F.lds + 32768);
      for (int it = blockIdx.x; it < 212; it += F.G) {
          if (it < 208) {
              for (int e = F.tid; e < NB_ * D_; e += NTHR) { const float c = a.in[I_C][e]; xs[e] = c / (1.0f + __expf(-c)); }
              __syncthreads();
              if (it < 192) { const int l = it / 48, ch = it - l * 48;
                  gemv_item<4, D_>(a.in[I_MODW] + (size_t)l * D_ * 12288, 12288, ch * 256, xs, red, a.in[I_MODB] + l * 12288, (float*)(ws + WS_MODV) + (size_t)l * 4 * 12288, 12288, F); }
              else { const int ch = it - 192;
                  gemv_item<4, D_>(a.in[I_KVMODW], 4096, ch * 256, xs, red, a.in[I_KVMODB], (float*)(ws + WS_KVMOD), 4096, F); }
          } else { const int lt = it - 208;
              for (int e = F.tid; e < 4096; e += NTHR) xs[e] = a.in[I_APE][(size_t)lt * 4096 + e];
              __syncthreads();
              gemv_item<1, 4096>(a.in[I_AW1] + (size_t)lt * 4096 * 256, 256, 0, xs, red, nullptr, (float*)(ws + WS_PEB) + lt * 256, 256, F); }
      } }
    __syncthreads();
    { LAS float* scr = (LAS float*)(F.lds + F.wave * 16640);
      const int gw = blockIdx.x * NWAVES + F.wave, NGW = F.G * NWAVES;
      constexpr int C_AIN = 32 * (NPROJ / 64), C_SQ = 32 * 32, C_KV = 32 * 64, C_FIN = 32 * (2 * DFF / 64), C_FOUT = (DFF / 64) * 32, C_W1 = 64 * 4, C_W2 = 4 * 2, C_WG = 32;
      constexpr int NITEMS = 2 * C_AIN + 6 * C_SQ + C_KV + 4 * C_FIN + 4 * C_FOUT + 4 * C_W1 + 4 * C_W2 + 2 * C_WG;
      for (int it = gw; it < NITEMS; it += NGW) {
          int r = it;
          if (r < 4 * C_FIN) { const int l = r / C_FIN; r -= l * C_FIN; p0_transpose_item<1>(a.in[I_FWIN] + (size_t)l * D_ * 2 * DFF, D_, 2 * DFF, (bf16*)(ws + WS_WFIN + l * SZ_WFIN), scr, r, 2 * DFF / 64, F.lane); continue; } r -= 4 * C_FIN;
          if (r < 4 * C_FOUT) { const int l = r / C_FOUT; r -= l * C_FOUT; p0_transpose_item<0>(a.in[I_FWOUT] + (size_t)l * DFF * D_, DFF, D_, (bf16*)(ws + WS_WFOUT + l * SZ_WFOUT), scr, r, D_ / 64, F.lane); continue; } r -= 4 * C_FOUT;
          if (r < 2 * C_AIN) { const int l = r / C_AIN; r -= l * C_AIN; p0_transpose_item<2>(a.in[I_AWIN] + (size_t)l * D_ * NIN, D_, NIN, (bf16*)(ws + WS_WAIN + l * SZ_WAIN), scr, r, NPROJ / 64, F.lane); continue; } r -= 2 * C_AIN;
          if (r < 2 * C_SQ) { const int l = r / C_SQ; r -= l * C_SQ; p0_transpose_item<0>(a.in[I_AWOUT] + (size_t)l * D_ * D_, D_, D_, (bf16*)(ws + WS_WAOUT + l * SZ_WSQ), scr, r, D_ / 64, F.lane); continue; } r -= 2 * C_SQ;
          if (r < 2 * C_SQ) { const int l = r / C_SQ; r -= l * C_SQ; p0_transpose_item<0>(a.in[I_BWQ] + (size_t)l * D_ * D_, D_, D_, (bf16*)(ws + WS_WBQ + l * SZ_WSQ), scr, r, D_ / 64, F.lane); continue; } r -= 2 * C_SQ;
          if (r < 2 * C_SQ) { const int l = r / C_SQ; r -= l * C_SQ; p0_transpose_item<0>(a.in[I_BWOUT] + (size_t)l * D_ * D_, D_, D_, (bf16*)(ws + WS_WBOUT + l * SZ_WSQ), scr, r, D_ / 64, F.lane); continue; } r -= 2 * C_SQ;
          if (r < C_KV) { p0_transpose_item<0>(a.in[I_KVW], D_, 2 * D_, (bf16*)(ws + WS_WKV), scr, r, 2 * D_ / 64, F.lane); continue; } r -= C_KV;
          if (r < 4 * C_W1) { const int l = r / C_W1; r -= l * C_W1; p0_transpose_item<0, 1>(a.in[I_AW1] + (size_t)l * 4096 * 256, 4096, 256, (bf16*)(ws + WS_WC1 + l * SZ_WC1), scr, r, 4, F.lane); continue; } r -= 4 * C_W1;
          if (r < 4 * C_W2) { const int l = r / C_W2; r -= l * C_W2; p0_transpose_item<0>(a.in[I_AW2] + (size_t)l * 256 * 128, 256, 128, (bf16*)(ws + WS_WC2 + l * SZ_WC2), scr, r, 2, F.lane); continue; } r -= 4 * C_W2;
          { const int l = r / C_WG; r -= l * C_WG; p0_transpose_item<3, 2>(a.in[I_AWIN] + (size_t)l * D_ * NIN, D_, NIN, (bf16*)(ws + WS_WG + l * SZ_WG), scr, r, 1, F.lane); }
      } }
}

struct NormRow { f32x4 x[8]; bf16x8 y[4]; };
struct NormArgs { const void* xin; const bf16* y; const float* gate; const float* ng_y; void* xout; const float* ng_h; const float* sh; const float* sc; bf16* h; const float* ng_k; const float* ksh; const float* ksc; bf16* hk; };
__device__ __forceinline__ void bf8_to_f32(const bf16x8& v, f32x4& a, f32x4& b) { const u32x4 w = *reinterpret_cast<const u32x4*>(&v);
    a = (f32x4){__uint_as_float(w.x << 16), __uint_as_float(w.x & 0xffff0000u), __uint_as_float(w.y << 16), __uint_as_float(w.y & 0xffff0000u)};
    b = (f32x4){__uint_as_float(w.z << 16), __uint_as_float(w.z & 0xffff0000u), __uint_as_float(w.w << 16), __uint_as_float(w.w & 0xffff0000u)}; }
template <bool XIN16> __device__ __forceinline__ void norm_load(NormRow& R, const NormArgs& A, int m, int lane) {
    const size_t ro = (size_t)m * D_ + 8 * lane;
    if (XIN16) {
#pragma unroll
        for (int j = 0; j < 4; ++j) { const bf16x8 v = *(const bf16x8*)((const bf16*)A.xin + ro + 512 * j); *reinterpret_cast<bf16x8*>(&R.x[2 * j]) = v; }
    } else {
#pragma unroll
        for (int j = 0; j < 4; ++j) { R.x[2 * j] = *(const f32x4*)((const float*)A.xin + ro + 512 * j); R.x[2 * j + 1] = *(const f32x4*)((const float*)A.xin + ro + 512 * j + 4); }
    }
    if (A.y) {
#pragma unroll
        for (int j = 0; j < 4; ++j) R.y[j] = *(const bf16x8*)(A.y + ro + 512 * j);
    }
}
template <bool XIN16, bool XOUT16> __device__ __forceinline__ void norm_process(NormRow& R, const NormArgs& A, int m, int lane) {
    const int b = m >> 12; const size_t ro = (size_t)m * D_ + 8 * lane;
    if (XIN16) {
#pragma unroll
        for (int j = 0; j < 4; ++j) { const bf16x8 v = *reinterpret_cast<const bf16x8*>(&R.x[2 * j]); bf8_to_f32(v, R.x[2 * j], R.x[2 * j + 1]); }
    }
    if (A.y) {
        f32x4 yv[8]; float ss = 0.f;
#pragma unroll
        for (int j = 0; j < 4; ++j) bf8_to_f32(R.y[j], yv[2 * j], yv[2 * j + 1]);
#pragma unroll
        for (int j = 0; j < 8; ++j) ss += (yv[j][0] * yv[j][0] + yv[j][1] * yv[j][1]) + (yv[j][2] * yv[j][2] + yv[j][3] * yv[j][3]);
        const float r = 1.0f / sqrtf(wave_sum(ss) * (1.0f / D_) + EPS);
#pragma unroll
        for (int j = 0; j < 8; ++j) { const int col = 8 * lane + 512 * (j >> 1) + 4 * (j & 1); const f32x4 gv = *(const f32x4*)(A.gate + (size_t)b * 12288 + col), nv = *(const f32x4*)(A.ng_y + col);
            R.x[j] = R.x[j] + gv * ((yv[j] * r) * nv);
            if (!XOUT16) *(f32x4*)((float*)A.xout + ro + 512 * (j >> 1) + 4 * (j & 1)) = R.x[j]; }
        if (XOUT16) {
#pragma unroll
            for (int j = 0; j < 4; ++j) { u32x4 w; w.x = cvtpk(R.x[2 * j][0], R.x[2 * j][1]); w.y = cvtpk(R.x[2 * j][2], R.x[2 * j][3]); w.z = cvtpk(R.x[2 * j + 1][0], R.x[2 * j + 1][1]); w.w = cvtpk(R.x[2 * j + 1][2], R.x[2 * j + 1][3]);
                *(u32x4*)((bf16*)A.xout + ro + 512 * j) = w;
                bf8_to_f32(*reinterpret_cast<const bf16x8*>(&w), R.x[2 * j], R.x[2 * j + 1]); }
        }
    }
    if (A.h || A.hk) {
        float ss = 0.f;
#pragma unroll
        for (int j = 0; j < 8; ++j) ss += (R.x[j][0] * R.x[j][0] + R.x[j][1] * R.x[j][1]) + (R.x[j][2] * R.x[j][2] + R.x[j][3] * R.x[j][3]);
        const float r = 1.0f / sqrtf(wave_sum(ss) * (1.0f / D_) + EPS);
        if (A.h) {
#pragma unroll
            for (int j = 0; j < 4; ++j) { const int col = 8 * lane + 512 * j; u32x4 w;
                { const f32x4 nv = *(const f32x4*)(A.ng_h + col), sv = *(const f32x4*)(A.sc + (size_t)b * 12288 + col), hv = *(const f32x4*)(A.sh + (size_t)b * 12288 + col);
                  const f32x4 o = ((R.x[2 * j] * r) * nv) * (sv + 1.0f) + hv; w.x = cvtpk(o[0], o[1]); w.y = cvtpk(o[2], o[3]); }
                { const f32x4 nv = *(const f32x4*)(A.ng_h + col + 4), sv = *(const f32x4*)(A.sc + (size_t)b * 12288 + col + 4), hv = *(const f32x4*)(A.sh + (size_t)b * 12288 + col + 4);
                  const f32x4 o = ((R.x[2 * j + 1] * r) * nv) * (sv + 1.0f) + hv; w.z = cvtpk(o[0], o[1]); w.w = cvtpk(o[2], o[3]); }
                *(u32x4*)(A.h + ro + 512 * j) = w; }
        }
        if (A.hk) {
#pragma unroll
            for (int j = 0; j < 4; ++j) { const int col = 8 * lane + 512 * j; u32x4 w;
                { const f32x4 nv = *(const f32x4*)(A.ng_k + col), sv = *(const f32x4*)(A.ksc + (size_t)b * 4096 + col), hv = *(const f32x4*)(A.ksh + (size_t)b * 4096 + col);
                  const f32x4 o = ((R.x[2 * j] * r) * nv) * (sv + 1.0f) + hv; w.x = cvtpk(o[0], o[1]); w.y = cvtpk(o[2], o[3]); }
                { const f32x4 nv = *(const f32x4*)(A.ng_k + col + 4), sv = *(const f32x4*)(A.ksc + (size_t)b * 4096 + col + 4), hv = *(const f32x4*)(A.ksh + (size_t)b * 4096 + col + 4);
                  const f32x4 o = ((R.x[2 * j + 1] * r) * nv) * (sv + 1.0f) + hv; w.z = cvtpk(o[0], o[1]); w.w = cvtpk(o[2], o[3]); }
                *(u32x4*)(A.hk + ro + 512 * j) = w; }
        }
    }
}
template <bool XIN16, bool XOUT16> __device__ __forceinline__ void norm_process_r(NormRow& R, const NormArgs& A, int m, int lane, const f32x4 (&pa)[8], const f32x4 (&pm)[8], const LAS float* lv) {
    const int b = m >> 12; const size_t ro = (size_t)m * D_ + 8 * lane;
    if (XIN16) {
#pragma unroll
        for (int j = 0; j < 4; ++j) { const bf16x8 v = *reinterpret_cast<const bf16x8*>(&R.x[2 * j]); bf8_to_f32(v, R.x[2 * j], R.x[2 * j + 1]); }
    }
    if (A.y) {
        f32x4 yv[8]; float ss = 0.f;
#pragma unroll
        for (int j = 0; j < 4; ++j) bf8_to_f32(R.y[j], yv[2 * j], yv[2 * j + 1]);
#pragma unroll
        for (int j = 0; j < 8; ++j) ss += (yv[j][0] * yv[j][0] + yv[j][1] * yv[j][1]) + (yv[j][2] * yv[j][2] + yv[j][3] * yv[j][3]);
        const float r = 1.0f / sqrtf(wave_sum(ss) * (1.0f / D_) + EPS);
#pragma unroll
        for (int j = 0; j < 8; ++j) { R.x[j] = R.x[j] + pa[j] * (yv[j] * r);
            if (!XOUT16) *(f32x4*)((float*)A.xout + ro + 512 * (j >> 1) + 4 * (j & 1)) = R.x[j]; }
        if (XOUT16) {
#pragma unroll
            for (int j = 0; j < 4; ++j) { u32x4 w; w.x = cvtpk(R.x[2 * j][0], R.x[2 * j][1]); w.y = cvtpk(R.x[2 * j][2], R.x[2 * j][3]); w.z = cvtpk(R.x[2 * j + 1][0], R.x[2 * j + 1][1]); w.w = cvtpk(R.x[2 * j + 1][2], R.x[2 * j + 1][3]);
                *(u32x4*)((bf16*)A.xout + ro + 512 * j) = w;
                bf8_to_f32(*reinterpret_cast<const bf16x8*>(&w), R.x[2 * j], R.x[2 * j + 1]); }
        }
    }
    if (A.h || A.hk) {
        float ss = 0.f;
#pragma unroll
        for (int j = 0; j < 8; ++j) ss += (R.x[j][0] * R.x[j][0] + R.x[j][1] * R.x[j][1]) + (R.x[j][2] * R.x[j][2] + R.x[j][3] * R.x[j][3]);
        const float r = 1.0f / sqrtf(wave_sum(ss) * (1.0f / D_) + EPS);
        if (A.h) {
#pragma unroll
            for (int j = 0; j < 4; ++j) { u32x4 w; const LAS float* shp = lv + 8 * lane + 512 * j;
                { const f32x4 o = (R.x[2 * j] * r) * pm[2 * j] + *(const LAS f32x4*)shp; w.x = cvtpk(o[0], o[1]); w.y = cvtpk(o[2], o[3]); }
                { const f32x4 o = (R.x[2 * j + 1] * r) * pm[2 * j + 1] + *(const LAS f32x4*)(shp + 4); w.z = cvtpk(o[0], o[1]); w.w = cvtpk(o[2], o[3]); }
                *(u32x4*)(A.h + ro + 512 * j) = w; }
        }
        if (A.hk) {
#pragma unroll
            for (int j = 0; j < 4; ++j) { const int col = 8 * lane + 512 * j; u32x4 w;
                { const f32x4 o = (R.x[2 * j] * r) * *(const LAS f32x4*)(lv + 2048 + col) + *(const LAS f32x4*)(lv + 4096 + col); w.x = cvtpk(o[0], o[1]); w.y = cvtpk(o[2], o[3]); }
                { const f32x4 o = (R.x[2 * j + 1] * r) * *(const LAS f32x4*)(lv + 2048 + col + 4) + *(const LAS f32x4*)(lv + 4096 + col + 4); w.z = cvtpk(o[0], o[1]); w.w = cvtpk(o[2], o[3]); }
                *(u32x4*)(A.hk + ro + 512 * j) = w; }
        }
    }
}
template <bool XIN16, bool XOUT16>
__device__ __forceinline__ void norm_phase(Frame& F, const void* xin, const bf16* y, const float* gate, const float* ng_y, void* xout,
                                           const float* ng_h, const float* sh, const float* sc, bf16* h,
                                           const float* ng_k, const float* ksh, const float* ksc, bf16* hk) {
    const NormArgs A{xin, y, gate, ng_y, xout, ng_h, sh, sc, h, ng_k, ksh, ksc, hk};
    const int gw = blockIdx.x * NWAVES + F.wave, NGW = F.G * NWAVES, lane = F.lane;
    if (F.G == 256) {
        const int m0 = ((((int)blockIdx.x & 7) * 32 + ((int)blockIdx.x >> 3)) * NWAVES + F.wave) * 8, b = m0 >> 12;
        LAS float* lv = (LAS float*)F.lds;
        { const int c4 = 4 * F.tid;
          if (h) *(LAS f32x4*)(lv + c4) = *(const f32x4*)(sh + (size_t)b * 12288 + c4);
          if (hk) { *(LAS f32x4*)(lv + 2048 + c4) = *(const f32x4*)(ng_k + c4) * (*(const f32x4*)(ksc + (size_t)b * 4096 + c4) + 1.0f); *(LAS f32x4*)(lv + 4096 + c4) = *(const f32x4*)(ksh + (size_t)b * 4096 + c4); } }
        __syncthreads();
        f32x4 pa[8], pm[8];
#pragma unroll
        for (int j = 0; j < 8; ++j) { const int col = 8 * lane + 512 * (j >> 1) + 4 * (j & 1);
            pa[j] = y ? *(const f32x4*)(gate + (size_t)b * 12288 + col) * *(const f32x4*)(ng_y + col) : (f32x4){0.f, 0.f, 0.f, 0.f};
            pm[j] = h ? *(const f32x4*)(ng_h + col) * (*(const f32x4*)(sc + (size_t)b * 12288 + col) + 1.0f) : (f32x4){0.f, 0.f, 0.f, 0.f};
            }
        NormRow RA, RB;
        norm_load<XIN16>(RA, A, m0, lane);
#pragma unroll 1
        for (int k = 0; k < 8; k += 2) {
            norm_load<XIN16>(RB, A, m0 + k + 1, lane);
            norm_process_r<XIN16, XOUT16>(RA, A, m0 + k, lane, pa, pm, lv);
            if (k + 2 < 8) norm_load<XIN16>(RA, A, m0 + k + 2, lane);
            norm_process_r<XIN16, XOUT16>(RB, A, m0 + k + 1, lane, pa, pm, lv);
        }
        __syncthreads();
        return;
    }
    NormRow RA, RB;
    if (gw < M_) norm_load<XIN16>(RA, A, gw, lane);
    for (int m = gw; m < M_; m += 2 * NGW) {
        const int m2 = m + NGW, m3 = m + 2 * NGW;
        if (m2 < M_) norm_load<XIN16>(RB, A, m2, lane);
        norm_process<XIN16, XOUT16>(RA, A, m, lane);
        if (m3 < M_) norm_load<XIN16>(RA, A, m3, lane);
        if (m2 < M_) norm_process<XIN16, XOUT16>(RB, A, m2, lane);
    }
}

__device__ __forceinline__ void gate_phase(Frame& F, const bf16* H, const bf16* WG, const float* gate_b, float* GATES) {
    LAS float* red = (LAS float*)F.lds;
    const int r = F.lane & 31, hh = F.lane >> 5, w = F.wave, rt = w >> 2, kq = w & 3, wrow = F.lane >> 3, wpc = F.lane & 7;
    LAS char* abuf = (LAS char*)F.lds + 65536 + w * 4608;
    for (int it = blockIdx.x; it < M_ / 64; it += F.G) {
        const int row0 = it * 64;
        const bf16* ap = H + (size_t)(row0 + 32 * rt + wrow) * D_ + kq * 512 + 8 * wpc;
        const bf16* bp = WG + ((size_t)(kq * 8) * 4 * 64 + F.lane) * 8;
        f32x16 a0 = {}, a1 = {};
#define GT_LD(S, ch) bf16x8 S##_a[4], S##_p[4], S##_q[4]; _Pragma("unroll") for (int j = 0; j < 4; ++j) { S##_a[j] = *(const bf16x8*)(ap + (size_t)(8 * j) * D_ + 64 * (ch)); \
            S##_p[j] = *(const bf16x8*)(bp + ((size_t)(ch) * 4 + j) * 512); S##_q[j] = *(const bf16x8*)(bp + (size_t)32 * 4 * 512 + ((size_t)(ch) * 4 + j) * 512); }
#define GT_MM(S) { _Pragma("unroll") for (int j = 0; j < 4; ++j) *(LAS bf16x8*)(abuf + (wrow + 8 * j) * 144 + wpc * 16) = S##_a[j]; \
            bf16x8 af[4]; _Pragma("unroll") for (int j = 0; j < 4; ++j) af[j] = *(const LAS bf16x8*)(abuf + r * 144 + (4 * hh + j) * 16); \
            _Pragma("unroll") for (int j = 0; j < 4; ++j) { a0 = __builtin_amdgcn_mfma_f32_32x32x16_bf16(af[j], S##_p[j], a0, 0, 0, 0); a1 = __builtin_amdgcn_mfma_f32_32x32x16_bf16(af[j], S##_q[j], a1, 0, 0, 0); } }
        GT_LD(c0, 0) GT_LD(c1, 1)
        GT_LD(c2, 2) GT_MM(c0) GT_LD(c3, 3) GT_MM(c1) GT_LD(c4, 4) GT_MM(c2) GT_LD(c5, 5) GT_MM(c3) GT_LD(c6, 6) GT_MM(c4) GT_LD(c7, 7) GT_MM(c5) GT_MM(c6) GT_MM(c7)
#undef GT_LD
#undef GT_MM
#pragma unroll
        for (int i = 0; i < 16; ++i) { red[((w * 2 + 0) * 16 + i) * 64 + F.lane] = a0[i]; red[((w * 2 + 1) * 16 + i) * 64 + F.lane] = a1[i]; }
        __syncthreads();
        for (int e = F.tid; e < 4096; e += NTHR) { const int ln = e & 63, i = (e >> 6) & 15, ct = (e >> 10) & 1, rt2 = e >> 11;
            float v = 0.f;
#pragma unroll
            for (int q = 0; q < 4; ++q) v += red[(((rt2 * 4 + q) * 2 + ct) * 16 + i) * 64 + ln];
            const int col = 32 * ct + (ln & 31), row = row0 + 32 * rt2 + (i & 3) + 8 * (i >> 2) + 4 * (ln >> 5);
            if (col < 48) GATES[(size_t)row * 48 + col] = 1.0f / (1.0f + __expf(-(v + gate_b[col]))); }
        __syncthreads();
    }
}

__device__ __forceinline__ void compress_phase(Frame& F, const bf16* KV6, const bf16* WC1, const bf16* WC2, const float* PEB, bf16* KCMP) {
    LAS char* ldsb = (LAS char*)F.lds;
    LAS bf16* Hs = (LAS bf16*)F.lds;
    const int r = F.lane & 31, hh = F.lane >> 5, w = F.wave;
    for (int u = blockIdx.x; u < 256; u += F.G) {
        const int t = u >> 7, b = (u >> 5) & 3, g = (u >> 3) & 3, n0 = (u & 7) * 32;
        const bf16* src = KV6 + (size_t)t * M_ * 512 + (size_t)b * S_ * 512 + g * 128;
        { bf16x8 v[17];
#pragma unroll
          for (int i = 0; i < 17; ++i) { const int q = F.tid + 512 * i, row = q >> 4, c = q & 15; int tok = 16 * n0 + row; tok = tok > S_ - 1 ? S_ - 1 : tok;
              if (q < 528 * 16) v[i] = *(const bf16x8*)(src + (size_t)tok * 512 + c * 8); }
#pragma unroll
          for (int i = 0; i < 17; ++i) { const int q = F.tid + 512 * i, row = q >> 4, c = q & 15;
              if (q < 528 * 16) *(LAS bf16x8*)(ldsb + row * 256 + ((c ^ ((row >> 4) & 15)) << 4)) = v[i]; } }
        __syncthreads();
        const bf16* wfrag = WC1 + (size_t)t * 256 * 4096 + ((size_t)w * 256 * 64 + F.lane) * 8;
        f32x16 acc = {};
        bf16x8 b0[8], b1[8];
#pragma unroll
        for (int dd = 0; dd < 8; ++dd) b0[dd] = *(const bf16x8*)(wfrag + (size_t)dd * 512);
#define CMP_STEP(LT, BC, BN) do { const int lt_ = (LT); \
            if (lt_ + 1 < 32) { _Pragma("unroll") for (int dd = 0; dd < 8; ++dd) BN[dd] = *(const bf16x8*)(wfrag + (size_t)((lt_ + 1) * 8 + dd) * 512); } \
            const int row = 16 * r + lt_; const LAS char* arow = ldsb + row * 256; const int key = (row >> 4) & 15; \
            _Pragma("unroll") for (int dd = 0; dd < 8; ++dd) { const bf16x8 af = *(const LAS bf16x8*)(arow + (((2 * dd + hh) ^ key) << 4)); \
                acc = __builtin_amdgcn_mfma_f32_32x32x16_bf16(af, BC[dd], acc, 0, 0, 0); } } while (0)
        for (int lt = 0; lt < 32; lt += 2) { CMP_STEP(lt, b0, b1); CMP_STEP(lt + 1, b1, b0); }
#undef CMP_STEP
        __syncthreads();
        const float pb = PEB[t * 256 + 32 * w + r];
#pragma unroll
        for (int i = 0; i < 16; ++i) { const int row = (i & 3) + 8 * (i >> 2) + 4 * hh; const float x = acc[i] + pb;
            const float u2 = 1.5957691216057308f * (x + 0.044715f * x * x * x);
            const float gl = x / (1.0f + __expf(-u2));
            Hs[row * 264 + 32 * w + r] = (bf16)(cvtpk(gl, 0.f) & 0xffffu); }
        __syncthreads();
        if (w < 4) {
            f32x16 a2 = {};
            const bf16* w2row = WC2 + (size_t)t * 128 * 256 + (size_t)(32 * w + r) * 256 + 8 * hh;
#pragma unroll
            for (int ks = 0; ks < 16; ++ks) {
                const bf16x8 af = *(const LAS bf16x8*)(Hs + r * 264 + 16 * ks + 8 * hh);
                const bf16x8 bfr = *(const bf16x8*)(w2row + 16 * ks);
                a2 = __builtin_amdgcn_mfma_f32_32x32x16_bf16(af, bfr, a2, 0, 0, 0);
            }
            bf16* dst = KCMP + ((size_t)(t * 16 + b * 4 + g) * NCP) * HD + 32 * w + r;
#pragma unroll
            for (int i = 0; i < 16; ++i) { const int n = n0 + (i & 3) + 8 * (i >> 2) + 4 * hh;
                dst[(size_t)n * HD] = (n < 255) ? (bf16)(cvtpk(a2[i], 0.f) & 0xffffu) : (bf16)0; }
        }
        __syncthreads();
    }
}

#define KSWZ(row, colB) ((row) * 256 + ((colB) ^ (((row) & 7) << 4)))
constexpr int SHM_K = 16384, SHM_V = 16384;
__device__ __forceinline__ int v_st(int k, int c) { const int kk = (k & ~0xC) | ((k & 4) << 1) | ((k & 8) >> 1); return ((kk >> 3) * 4 + (c >> 5)) * 512 + ((kk & 7) * 32 + (c & 31)) * 2; }
__device__ __forceinline__ int v_rd_base(int lane) { return ((lane & 3) << 3) | (((lane >> 2) & 3) << 6) | (((lane >> 4) & 1) << 5) | (((lane >> 5) & 1) << 8); }
constexpr int v_rd_off(int d0, int ks, int half) { return d0 * 512 + ks * 4096 + half * 2048; }
__device__ __forceinline__ int crow(int r, int hi) { return (r & 3) + 8 * (r >> 2) + 4 * hi; }
__device__ __forceinline__ float xhalf(float v, int hi) {
    auto rr = __builtin_amdgcn_permlane32_swap(__float_as_uint(v), __float_as_uint(v), false, false);
    return __uint_as_float(hi ? rr[0] : rr[1]);
}
struct StageRegs { bf16x8 k0, k1, v0, v1; };
template <bool DOV> __device__ __forceinline__ void stage_load(StageRegs& s, const bf16* K, const bf16* V, int stride, int key0, int sr, int sc) {
    s.k0 = *(const bf16x8*)(K + (size_t)(key0 + sr) * stride + sc); s.k1 = *(const bf16x8*)(K + (size_t)(key0 + 32 + sr) * stride + sc);
    if (DOV) { s.v0 = *(const bf16x8*)(V + (size_t)(key0 + sr) * stride + sc); s.v1 = *(const bf16x8*)(V + (size_t)(key0 + 32 + sr) * stride + sc); }
}
template <bool DOV> __device__ __forceinline__ void stage_write(const StageRegs& s, LAS char* Kb, LAS char* Vb, int sr, int sc) {
    const int kws = KSWZ(sr, sc * 2);
    *(LAS bf16x8*)(Kb + kws) = s.k0; *(LAS bf16x8*)(Kb + kws + 32 * 256) = s.k1;
    if (DOV) { *(LAS bf16x8*)(Vb + v_st(sr, sc)) = s.v0; *(LAS bf16x8*)(Vb + v_st(32 + sr, sc)) = s.v1; }
}
__device__ __forceinline__ void qkt(f32x16& p0, f32x16& p1, const LAS char* Kb, int r32, int hi, const bf16x8 (&qr)[8]) {
    p0 = f32x16{}; p1 = f32x16{};
    const LAS char* kb[4];
#pragma unroll
    for (int dd = 0; dd < 4; ++dd) kb[dd] = Kb + KSWZ(r32, (dd * 16 + hi * 8) * 2);
#define QK_RD(B, d0a) const bf16x8 B##0 = *(const LAS bf16x8*)(kb[(d0a) & 3] + ((d0a) >> 2) * 128), B##1 = *(const LAS bf16x8*)(kb[(d0a) & 3] + ((d0a) >> 2) * 128 + 32 * 256), \
                      B##2 = *(const LAS bf16x8*)(kb[((d0a) + 1) & 3] + (((d0a) + 1) >> 2) * 128), B##3 = *(const LAS bf16x8*)(kb[((d0a) + 1) & 3] + (((d0a) + 1) >> 2) * 128 + 32 * 256)
#define QK_MM(B, d0a) do { p0 = __builtin_amdgcn_mfma_f32_32x32x16_bf16(B##0, qr[d0a], p0, 0, 0, 0); p1 = __builtin_amdgcn_mfma_f32_32x32x16_bf16(B##1, qr[d0a], p1, 0, 0, 0); \
                           p0 = __builtin_amdgcn_mfma_f32_32x32x16_bf16(B##2, qr[(d0a) + 1], p0, 0, 0, 0); p1 = __builtin_amdgcn_mfma_f32_32x32x16_bf16(B##3, qr[(d0a) + 1], p1, 0, 0, 0); } while (0)
    QK_RD(ka, 0); QK_RD(kc, 2); SBAR();
    QK_MM(ka, 0); QK_RD(ke, 4); SBAR();
    QK_MM(kc, 2); QK_RD(kg, 6); SBAR();
    QK_MM(ke, 4); SBAR();
    QK_MM(kg, 6);
#undef QK_RD
#undef QK_MM
}
__device__ __forceinline__ void pack_p(const f32x16& p0, const f32x16& p1, bf16x8& pa0, bf16x8& pa1, bf16x8& pa2, bf16x8& pa3) {
#define PK4(P, B_, OUT) do { unsigned a0 = cvtpk(P[B_+0], P[B_+1]), a1 = cvtpk(P[B_+2], P[B_+3]);                          \
        unsigned b0 = cvtpk(P[B_+4], P[B_+5]), b1 = cvtpk(P[B_+6], P[B_+7]);                                             \
        auto r0 = __builtin_amdgcn_permlane32_swap(a0, b0, false, false); auto r1 = __builtin_amdgcn_permlane32_swap(a1, b1, false, false); \
        u32x4 w = {r0[0], r1[0], r0[1], r1[1]}; OUT = *reinterpret_cast<bf16x8*>(&w); } while (0)
    PK4(p0, 0, pa0); PK4(p0, 8, pa1); PK4(p1, 0, pa2); PK4(p1, 8, pa3);
#undef PK4
}
__device__ __forceinline__ void pv_tile(f32x16 (&o)[4], int vb, bf16x8 pa0, bf16x8 pa1, bf16x8 pa2, bf16x8 pa3) {
    const LAS char* vp = (const LAS char*)(uintptr_t)(unsigned)vb;
#define TRRD(off) __builtin_amdgcn_ds_read_tr16_b64_v4i16((LAS s16x4*)(vp + (off)))
#define TRB(off) __builtin_shufflevector(TRRD(off), TRRD((off) + 2048), 0, 1, 2, 3, 4, 5, 6, 7)
#define PV_D0(d0) do { constexpr int b_ = v_rd_off(d0, 0, 0); \
        const bf16x8 v0 = TRB(b_), v1 = TRB(b_ + 4096), v2 = TRB(b_ + 8192), v3 = TRB(b_ + 12288); \
        o[d0] = __builtin_amdgcn_mfma_f32_32x32x16_bf16(pa0, v0, o[d0], 0, 0, 0);   \
        o[d0] = __builtin_amdgcn_mfma_f32_32x32x16_bf16(pa1, v1, o[d0], 0, 0, 0);   \
        o[d0] = __builtin_amdgcn_mfma_f32_32x32x16_bf16(pa2, v2, o[d0], 0, 0, 0);   \
        o[d0] = __builtin_amdgcn_mfma_f32_32x32x16_bf16(pa3, v3, o[d0], 0, 0, 0); } while (0)
    PV_D0(0); PV_D0(1); PV_D0(2); PV_D0(3);
#undef PV_D0
#undef TRB
#undef TRRD
}

template <int MODE, bool IMP, bool DOPV>
__device__ __forceinline__ void attn_pass(Frame& F, LAS char* lds, const bf16* K, const bf16* V, int stride, unsigned long long tiles,
                                          const bf16x8 (&qr)[8], int klo, int khi, int u_klo_max, int u_khi_min, unsigned long long bmask, float& m, float& l, float rl, float gate,
                                          f32x16 (&o)[4], LAS float* impA, LAS float* impB, int tokl, LAS float* alw) {
    if (tiles == 0ull) return;
    constexpr bool NEEDV = (MODE == 2) || (MODE == 1 && DOPV);
    int tid_ = F.tid; asm volatile("" : "+v"(tid_));
    const int lane = tid_ & 63, r32 = lane & 31, hi = lane >> 5, sr = tid_ >> 4, sc = (tid_ & 15) * 8;
    const int vb0 = (int)(uintptr_t)(lds + 2 * SHM_K) + v_rd_base(lane);
    const float NEG = -__builtin_inff();
    StageRegs st;
    int j = __builtin_ctzll(tiles); tiles &= tiles - 1;
    stage_load<NEEDV>(st, K, V, stride, j * 64, sr, sc);
    stage_write<NEEDV>(st, lds, lds + 2 * SHM_K, sr, sc);
    __syncthreads();
    int buf = 0;
    for (;;) {
        const bool more = tiles != 0ull; int jn = 0;
        if (more) { jn = __builtin_ctzll(tiles); tiles &= tiles - 1; stage_load<NEEDV>(st, K, V, stride, jn * 64, sr, sc); }
        f32x16 p0, p1;
        qkt(p0, p1, lds + buf * SHM_K, r32, hi, qr);
        const bool bit = (bmask >> j) & 1ull;
        if (j * 64 < u_klo_max || j * 64 + 63 > u_khi_min) {
            const int kb = j * 64 + 4 * hi;
#pragma unroll
            for (int r = 0; r < 16; ++r) { const int k0 = kb + (r & 3) + 8 * (r >> 2), k1 = k0 + 32;
                if (!(k0 >= klo && k0 <= khi)) p0[r] = NEG;
                if (!(k1 >= klo && k1 <= khi)) p1[r] = NEG; }
        }
        if (MODE == 0 || MODE == 2) {
            float tmax = p0[0];
#pragma unroll
            for (int r = 1; r < 16; ++r) tmax = fmaxf(tmax, p0[r]);
#pragma unroll
            for (int r = 0; r < 16; ++r) tmax = fmaxf(tmax, p1[r]);
            tmax = bit ? tmax : NEG;
            tmax = fmaxf(tmax, xhalf(tmax, hi));
            if (MODE == 0) {
                const float mn = fmaxf(m, tmax), mb = bit ? -mn * C2 : NEG;
                float ps = 0.f;
#pragma unroll
                for (int r = 0; r < 16; ++r) ps += __builtin_amdgcn_exp2f(fmaf(p0[r], C2, mb)) + __builtin_amdgcn_exp2f(fmaf(p1[r], C2, mb));
                ps += xhalf(ps, hi);
                l = l * __builtin_amdgcn_exp2f((m - mn) * C2) + ps; m = mn;
            } else {
                if (!__all((tmax - m) * SCALE <= 8.0f)) {
                    const float mn = fmaxf(m, tmax), alpha = __builtin_amdgcn_exp2f((m - mn) * C2);
                    l *= alpha; m = mn;
                    if (hi == 0) alw[r32] = alpha;
#pragma unroll
                    for (int r = 0; r < 16; ++r) { const float al = alw[crow(r, hi)];
#pragma unroll
                        for (int d0 = 0; d0 < 4; ++d0) o[d0][r] *= al; }
                }
                const float mb = bit ? -m * C2 : NEG;
                float ps = 0.f;
#pragma unroll
                for (int r = 0; r < 16; ++r) { p0[r] = __builtin_amdgcn_exp2f(fmaf(p0[r], C2, mb)); p1[r] = __builtin_amdgcn_exp2f(fmaf(p1[r], C2, mb)); ps += p0[r] + p1[r]; }
                ps += xhalf(ps, hi);
                l += ps;
                bf16x8 pa0, pa1, pa2, pa3;
                pack_p(p0, p1, pa0, pa1, pa2, pa3);
                pv_tile(o, vb0 + buf * SHM_V, pa0, pa1, pa2, pa3);
            }
        } else {
            const float mb = bit ? -m * C2 : NEG;
#pragma unroll
            for (int r = 0; r < 16; ++r) { p0[r] = __builtin_amdgcn_exp2f(fmaf(p0[r], C2, mb)) * rl; p1[r] = __builtin_amdgcn_exp2f(fmaf(p1[r], C2, mb)) * rl; }
            if (IMP) {
#pragma unroll
                for (int pi = 0; pi < 2; ++pi)
#pragma unroll
                    for (int q = 0; q < 4; ++q) {
                        float qs, last;
                        if (pi == 0) { qs = (p0[4 * q] + p0[4 * q + 1]) + (p0[4 * q + 2] + p0[4 * q + 3]); last = p0[4 * q + 3]; }
                        else { qs = (p1[4 * q] + p1[4 * q + 1]) + (p1[4 * q + 2] + p1[4 * q + 3]); last = p1[4 * q + 3]; }
                        qs += lx1(qs); qs += lx2(qs); last += lx1(last); last += lx2(last);
                        const int mb_ = 16 * j + 8 * pi + 2 * q + hi;
                        if ((r32 & 3) == 0) { impA[tokl * 64 + mb_] = qs; if (mb_ + 1 < 64) impB[tokl * 64 + mb_ + 1] = last; }
                    }
            }
            if (DOPV) {
#pragma unroll
                for (int r = 0; r < 16; ++r) { p0[r] *= gate; p1[r] *= gate; }
                bf16x8 pa0, pa1, pa2, pa3;
                pack_p(p0, p1, pa0, pa1, pa2, pa3);
                pv_tile(o, vb0 + buf * SHM_V, pa0, pa1, pa2, pa3);
            }
        }
        if (more) stage_write<NEEDV>(st, lds + (buf ^ 1) * SHM_K, lds + 2 * SHM_K + (buf ^ 1) * SHM_V, sr, sc);
        __syncthreads();
        if (!more) break;
        j = jn; buf ^= 1;
    }
}

constexpr int NSA_IMP_OFF = 65536, NSA_MASK_OFF = 65536 + 32768, NSA_ALW_OFF = NSA_MASK_OFF + 1024, NSA_PK2_OFF = 106496;
__device__ __forceinline__ void nsa_attn_phase(Frame& F, const bf16* Q, const bf16* KV6, const bf16* KCMP, const float* GATES, bf16* O, float* STASH) {
    LAS char* lds = (LAS char*)F.lds;
    LAS float* impA = (LAS float*)(lds + NSA_IMP_OFF); LAS float* impB = impA + 4096;
    LAS unsigned long long* MASK = (LAS unsigned long long*)(lds + NSA_MASK_OFF);
    const int lane = F.lane, w = F.wave, r32 = lane & 31, hi = lane >> 5;
    LAS float* alw = (LAS float*)(lds + NSA_ALW_OFF) + w * 32;
    (void)STASH;
    if (w >= 4) __builtin_amdgcn_s_setprio(1);
    for (int i = 0;; ++i) {
        int qt, bg;
        if (F.G == 256) {
            if (i >= 4) break;
            const int x = blockIdx.x & 7, k = blockIdx.x >> 3;
            bg = x + 8 * (i >> 1); qt = (i & 1) ? k : 63 - k;
        } else {
            const int idx = i * F.G + ((i & 1) ? (F.G - 1 - (int)blockIdx.x) : (int)blockIdx.x);
            if (idx >= 1024) break;
            qt = 63 - (idx >> 4); bg = idx & 15;
        }
        const int b = bg >> 2, g = bg & 3, t0 = qt * 64;
        const int tw0 = t0 + 8 * w;
        const int tokl = 8 * w + (r32 >> 2), t = t0 + tokl, head = 4 * g + (r32 & 3);
        const size_t rowQ = (size_t)b * S_ + t;
        bf16x8 qr[8];
#pragma unroll
        for (int d0 = 0; d0 < 8; ++d0) qr[d0] = *(const bf16x8*)(Q + rowQ * D_ + head * HD + d0 * 16 + hi * 8);
        float g_all[3]; { const float* gp_ = GATES + rowQ * 48 + head * 3; g_all[0] = gp_[0]; g_all[1] = gp_[1]; g_all[2] = gp_[2]; }
#define NSA_GATE(k) (g_all[k])
        for (int e = F.tid; e < 8192; e += NTHR) impA[e] = 0.f;
        __syncthreads();
        f32x16 o[4] = {};
        const size_t kvb = (size_t)b * S_ * 512 + g * 128, TS = (size_t)M_ * 512;
        { const int nvalid = t >= 31 ? (t - 15) >> 4 : 0, ntc = (((t0 + 48) >> 4) + 63) >> 6;
          const int nv_min = tw0 >= 31 ? (tw0 - 15) >> 4 : 0;
          const unsigned long long tc = (1ull << ntc) - 1ull;
          const bf16* Kc = KCMP + (size_t)bg * NCP * HD; const bf16* Vc = KCMP + (size_t)(16 + bg) * NCP * HD;
          float m_c = -1e30f, l_c = 0.f;
          attn_pass<0, false, false>(F, lds, Kc, Vc, HD, tc, qr, 0, nvalid - 1, 0, nv_min - 1, ~0ull, m_c, l_c, 0.f, 0.f, o, impA, impB, tokl, alw);
          const float rl_c = l_c > 0.f ? 1.0f / l_c : 0.f;
          attn_pass<1, true, true>(F, lds, Kc, Vc, HD, tc, qr, 0, nvalid - 1, 0, nv_min - 1, ~0ull, m_c, l_c, rl_c, NSA_GATE(0), o, impA, impB, tokl, alw); }
        __syncthreads();
        int lnk = F.lane; asm volatile("" : "+v"(lnk));
        { const bool forced = (lnk == 0) || (lnk == qt) || (lnk == qt - 1), avail = lnk <= qt;
          LAS unsigned* kbuf = (LAS unsigned*)(lds + w * 2048);
#pragma unroll
          for (int u = 0; u < 8; ++u) { const int tok = 8 * w + u; const float v = impA[tok * 64 + lnk] + impB[tok * 64 + lnk];
              kbuf[u * 64 + lnk] = forced ? 0xFFFFFFFFu : (avail ? __float_as_uint(v) + 64u : (unsigned)(63 - lnk)); }
#pragma unroll 1
          for (int u = 0; u < 8; ++u) {
              const unsigned key = kbuf[u * 64 + lnk]; int rank = 0;
              const int nq = ((qt > 15 ? qt : 15) >> 2) + 1;
#pragma unroll 4
              for (int q = 0; q < nq; ++q) { const u32x4 o4 = *(const LAS u32x4*)(kbuf + u * 64 + 4 * q);
                  rank += (o4.x > key ? 1 : 0) + (o4.y > key ? 1 : 0) + (o4.z > key ? 1 : 0) + (o4.w > key ? 1 : 0); }
              unsigned long long sel = __ballot(rank < 16);
              if (__builtin_popcount((unsigned)sel) + __builtin_popcount((unsigned)(sel >> 32)) != 16) {
                  unsigned T = 0u;
#pragma unroll 1
                  for (int bit = 30; bit >= 0; --bit) { const unsigned c = T | (1u << bit); const unsigned long long bl = __ballot(key >= c);
                      if (__builtin_popcount((unsigned)bl) + __builtin_popcount((unsigned)(bl >> 32)) >= 16) T = c; }
                  const unsigned long long gt = __ballot(key > T), eq = __ballot(key == T);
                  const int need = 16 - (__builtin_popcount((unsigned)gt) + __builtin_popcount((unsigned)(gt >> 32)));
                  const int pos = (int)__builtin_amdgcn_mbcnt_hi((unsigned)(eq >> 32), __builtin_amdgcn_mbcnt_lo((unsigned)eq, 0u));
                  sel = __ballot(key > T || (key == T && pos < need));
              }
              if (lnk == 0) MASK[8 * w + u] = sel; }
        }
        __syncthreads();
        const unsigned long long ts = (qt == 63) ? ~0ull : ((1ull << (qt + 1)) - 1ull);
#define NSA_PK(k) (*(LAS unsigned*)(lds + ((k) < 16 ? NSA_IMP_OFF + (k) * 2048 : NSA_PK2_OFF + ((k) - 16) * 2048) + stid * 4))
        const unsigned long long mymask0 = MASK[tokl];
        int stid = F.tid; asm volatile("" : "+v"(stid));
#pragma unroll
        for (int d0 = 0; d0 < 4; ++d0)
#pragma unroll
            for (int r2 = 0; r2 < 8; ++r2) NSA_PK(d0 * 8 + r2) = cvtpk(o[d0][2 * r2], o[d0][2 * r2 + 1]);
#pragma unroll
        for (int d0 = 0; d0 < 4; ++d0) o[d0] = f32x16{};
        { const unsigned long long mymask = mymask0;
          const bf16* Ks = KV6 + 2 * TS + kvb; const bf16* Vs = KV6 + 3 * TS + kvb;
          float m = -1e30f, l = 0.f;
          attn_pass<2, false, true>(F, lds, Ks, Vs, 512, ts, qr, 0, t, 0, tw0, mymask, m, l, 0.f, 0.f, o, impA, impB, tokl, alw);
          const float f = l > 0.f ? NSA_GATE(1) / l : 0.f;
          if (hi == 0) alw[r32] = f;
          float al[16];
#pragma unroll
          for (int r = 0; r < 16; ++r) al[r] = alw[crow(r, hi)];
#pragma unroll
          for (int d0 = 0; d0 < 4; ++d0)
#pragma unroll
              for (int r2 = 0; r2 < 8; ++r2) { const unsigned w_ = NSA_PK(d0 * 8 + r2);
                  const float a = o[d0][2 * r2] * al[2 * r2] + __uint_as_float(w_ << 16), c = o[d0][2 * r2 + 1] * al[2 * r2 + 1] + __uint_as_float(w_ & 0xffff0000u);
                  NSA_PK(d0 * 8 + r2) = cvtpk(a, c); }
#pragma unroll
          for (int d0 = 0; d0 < 4; ++d0) o[d0] = f32x16{}; }
        { const bf16* Kw = KV6 + 4 * TS + kvb; const bf16* Vw = KV6 + 5 * TS + kvb;
          const int jlo = qt >= 8 ? qt - 8 : 0; const unsigned long long tw = ts & ~((1ull << jlo) - 1ull);
          float m = -1e30f, l = 0.f;
          attn_pass<2, false, true>(F, lds, Kw, Vw, 512, tw, qr, t - 511, t, tw0 + 7 - 511, tw0, ~0ull, m, l, 0.f, 0.f, o, impA, impB, tokl, alw);
          const float f = l > 0.f ? NSA_GATE(2) / l : 0.f;
          if (hi == 0) alw[r32] = f;
          float al[16];
#pragma unroll
          for (int r = 0; r < 16; ++r) al[r] = alw[crow(r, hi)];
#pragma unroll
          for (int d0 = 0; d0 < 4; ++d0)
#pragma unroll
              for (int r2 = 0; r2 < 8; ++r2) { const unsigned w_ = NSA_PK(d0 * 8 + r2);
                  o[d0][2 * r2] = o[d0][2 * r2] * al[2 * r2] + __uint_as_float(w_ << 16); o[d0][2 * r2 + 1] = o[d0][2 * r2 + 1] * al[2 * r2 + 1] + __uint_as_float(w_ & 0xffff0000u); } }
        int ln2 = F.lane; asm volatile("" : "+v"(ln2)); const int r32s = ln2 & 31, his = ln2 >> 5;
        LAS char* ost = lds + w * 8192;
#pragma unroll
        for (int r = 0; r < 16; ++r) { LAS char* op = ost + crow(r, his) * 256 + r32s * 2;
#pragma unroll
            for (int d0 = 0; d0 < 4; ++d0) { const float v = o[d0][r], vn = lx1(v); if ((r32s & 1) == 0) *(LAS unsigned*)(op + d0 * 64) = cvtpk(v, vn); } }
        { bf16* ob = O + ((size_t)b * S_ + t0 + 8 * w) * D_ + (size_t)(4 * g) * HD + ln2 * 8;
#pragma unroll
          for (int i = 0; i < 8; ++i) { const u32x4 v = *(const LAS u32x4*)(ost + i * 1024 + ln2 * 16); *(u32x4*)(ob + (size_t)i * D_) = v; } }
    }
    __builtin_amdgcn_s_setprio(0);
}

constexpr int SB_DONE_OFF = 65536;
constexpr float SB_EPS = 9.094947e-13f;
__device__ __forceinline__ void sb_attn_phase(Frame& F, const bf16* Q, const bf16* Ksh, const bf16* Vsh, bf16* O) {
    LAS char* lds = (LAS char*)F.lds;
    LAS unsigned* DONE = (LAS unsigned*)(lds + SB_DONE_OFF);
    const int lane = F.lane, w = F.wave, r32 = lane & 31, hi = lane >> 5, sr = F.tid >> 4, sc = (F.tid & 15) * 8;
    const int vb0 = (int)(uintptr_t)(lds + 2 * SHM_K) + v_rd_base(lane);
    if (w >= 4) __builtin_amdgcn_s_setprio(1);
    for (int ui = 0, u0 = blockIdx.x; u0 < 1024; ++ui, u0 += F.G) {
        int u = u0;
        if (F.G == 256) { const int x = blockIdx.x & 7, q = ui * 32 + (blockIdx.x >> 3); u = ((x + 8 * (q >> 4)) << 4) | (q & 15); }
        const int qb = u & 15, bh = u >> 4, b = bh >> 4, h = bh & 15, t0 = qb * 256, rlo = t0 + 32 * w, t = rlo + r32;
        bf16x8 qr[8];
#pragma unroll
        for (int d0 = 0; d0 < 8; ++d0) qr[d0] = *(const bf16x8*)(Q + ((size_t)b * S_ + t) * D_ + h * HD + d0 * 16 + hi * 8);
        const bf16* Kp = Ksh + (size_t)b * S_ * D_ + h * HD; const bf16* Vp = Vsh + (size_t)b * S_ * D_ + h * HD;
        float carry = 1.0f; f32x16 o[4] = {};
        int j = (t0 >> 6) + 3, buf = 0, it = 0;
        StageRegs st;
        stage_load<true>(st, Kp, Vp, D_, j * 64, sr, sc);
        stage_write<true>(st, lds, lds + 2 * SHM_K, sr, sc);
        __syncthreads();
        for (;;) {
            const bool more = j > 0;
            if (more) stage_load<true>(st, Kp, Vp, D_, (j - 1) * 64, sr, sc);
            const int kb = j * 64;
            const bool wdone = __all(carry < SB_EPS);
            if (kb <= rlo + 30 && !wdone) {
                f32x16 p0, p1;
                qkt(p0, p1, lds + buf * SHM_K, r32, hi, qr);
                f32x16 om0, om1; const int kq = kb + 4 * hi;
                constexpr float SBK = -SCALE * 1.4426950408889634f, SBZ = 80.f * 1.4426950408889634f;
                if (kb + 63 < rlo) {
#pragma unroll
                    for (int r = 0; r < 16; ++r) {
                        { float y = p0[r] * SBK; y = fminf(fmaxf(y, -SBZ), SBZ); const float e = __builtin_amdgcn_exp2f(y), be = __builtin_amdgcn_rcpf(1.0f + e); p0[r] = be; om0[r] = e * be; }
                        { float y = p1[r] * SBK; y = fminf(fmaxf(y, -SBZ), SBZ); const float e = __builtin_amdgcn_exp2f(y), be = __builtin_amdgcn_rcpf(1.0f + e); p1[r] = be; om1[r] = e * be; } }
                } else {
#pragma unroll
                    for (int r = 0; r < 16; ++r) { const int k0 = kq + (r & 3) + 8 * (r >> 2), k1 = k0 + 32;
                        { float y = p0[r] * SBK; y = fminf(fmaxf(y, -SBZ), SBZ); const float e = __builtin_amdgcn_exp2f(y), be = __builtin_amdgcn_rcpf(1.0f + e);
                          const bool c = k0 < t; p0[r] = c ? be : 0.f; om0[r] = c ? e * be : 1.0f; }
                        { float y = p1[r] * SBK; y = fminf(fmaxf(y, -SBZ), SBZ); const float e = __builtin_amdgcn_exp2f(y), be = __builtin_amdgcn_rcpf(1.0f + e);
                          const bool c = k1 < t; p1[r] = c ? be : 0.f; om1[r] = c ? e * be : 1.0f; } }
                }
                float acc = carry;
#pragma unroll
                for (int uu = 7; uu >= 0; --uu) { const int q = uu & 3;
                    float a0, a1, a2, a3;
                    if (uu >= 4) { a0 = om1[4 * q]; a1 = om1[4 * q + 1]; a2 = om1[4 * q + 2]; a3 = om1[4 * q + 3]; } else { a0 = om0[4 * q]; a1 = om0[4 * q + 1]; a2 = om0[4 * q + 2]; a3 = om0[4 * q + 3]; }
                    const float pm = (a0 * a1) * (a2 * a3), pp = xhalf(pm, hi);
                    acc *= hi ? 1.0f : pp;
                    const float s3 = acc, s2 = s3 * a3, s1 = s2 * a2, s0 = s1 * a1;
                    if (uu >= 4) { p1[4 * q] *= s0; p1[4 * q + 1] *= s1; p1[4 * q + 2] *= s2; p1[4 * q + 3] *= s3; } else { p0[4 * q] *= s0; p0[4 * q + 1] *= s1; p0[4 * q + 2] *= s2; p0[4 * q + 3] *= s3; }
                    acc *= pm; acc *= hi ? pp : 1.0f; }
                carry = acc;
                bf16x8 pa0, pa1, pa2, pa3;
                pack_p(p0, p1, pa0, pa1, pa2, pa3);
                pv_tile(o, vb0 + buf * SHM_V, pa0, pa1, pa2, pa3);
            }
            if (lane == 0) DONE[(it & 1) * 8 + w] = __all(carry < SB_EPS) ? 1u : 0u;
            if (more) stage_write<true>(st, lds + (buf ^ 1) * SHM_K, lds + 2 * SHM_K + (buf ^ 1) * SHM_V, sr, sc);
            __syncthreads();
            if (!more) break;
            unsigned alld = 1u;
#pragma unroll
            for (int ww = 0; ww < 8; ++ww) alld &= DONE[(it & 1) * 8 + ww];
            if (alld) break;
            --j; buf ^= 1; ++it;
        }
        __syncthreads();
        { LAS char* ost = lds + 73728 + w * 8192;
#pragma unroll
          for (int r = 0; r < 16; ++r) { LAS char* op = ost + crow(r, hi) * 256 + r32 * 2;
#pragma unroll
              for (int d0 = 0; d0 < 4; ++d0) { const float v = o[d0][r], vn = lx1(v); if ((r32 & 1) == 0) *(LAS unsigned*)(op + d0 * 64) = cvtpk(v, vn); } }
          bf16* ob = O + ((size_t)b * S_ + rlo + (lane >> 4)) * D_ + h * HD + (lane & 15) * 8;
#pragma unroll
          for (int i = 0; i < 8; ++i) { const u32x4 v = *(const LAS u32x4*)(ost + i * 1024 + lane * 16); *(u32x4*)(ob + (size_t)(4 * i) * D_) = v; } }
    }
    __builtin_amdgcn_s_setprio(0);
}


constexpr int NPHASE = 2 + 8 * NLAYER;
#ifndef MK_MULTI
#define MK_MULTI 0
#endif
#ifndef PHMASK
#define PHMASK 0xFFFF
#endif
#define PHSEL(b) ((PHMASK >> (b)) & 1)
#ifndef PROBE_REP
#define PROBE_REP 0
#endif
#define NREP(b) (1 + ((PROBE_REP >> (b)) & 1))
__global__ void __launch_bounds__(NTHR, 2) yoco_fwd(Args args) {
    extern __shared__ __attribute__((aligned(16))) unsigned char lds_raw[];
    Frame F;
    F.lds = (LAS unsigned char*)lds_raw;
    const int wave_s = __builtin_amdgcn_readfirstlane((int)threadIdx.x >> 6);
    F.tid = mk_tid(wave_s); F.lane = F.tid & 63; F.wave = wave_s;
    F.G = gridDim.x; F.vcu = blockIdx.x; F.ws = args.ws;
    unsigned char* ws = args.ws;
    unsigned* ctl = (unsigned*)(ws + WS_CTL);
    volatile LAS unsigned* MISC = (volatile LAS unsigned*)(F.lds + MISC_OFF);
    for (int u = F.tid; u < (LDS_BYTES - LDSCTL_OFF) / 4; u += NTHR) ((LAS unsigned*)(F.lds + LDSCTL_OFF))[u] = 0u;
    __syncthreads();
    const int lo = args.ph_lo, hi = args.ph_hi;
    XcdBarrier bar; bar.bar = ctl + CW_BAR; bar.x = 0; bar.st = nullptr;
    if (hi - lo > 1) bar = xcd_barrier_post(ctl + CW_BAR, MISC + 8, F.tid == 0);
#define IN(k) (lo <= (k) && (k) < hi)
#define SEAM(k) do { if ((k) + 1 < hi) xcd_barrier(bar, mk_tid(wave_s) == 0); } while (0)
#define GSEAM(k) do { if ((k) + 1 < hi) { if (lo == 0) group_barrier(bar, mk_tid(wave_s)); else xcd_barrier(bar, mk_tid(wave_s) == 0); } } while (0)

#define DEF_BUFS \
    const float* MODV = (const float*)(ws + WS_MODV); \
    const float* KVMOD = (const float*)(ws + WS_KVMOD); \
    bf16* Hb = (bf16*)(ws + WS_H); bf16* HKb = (bf16*)(ws + WS_HK); bf16* Qb = (bf16*)(ws + WS_Q); bf16* KV6 = (bf16*)(ws + WS_KV6); \
    float* GATES = (float*)(ws + WS_GATES); bf16* KCMP = (bf16*)(ws + WS_KCMP); bf16* Ob = (bf16*)(ws + WS_O); bf16* Yb = (bf16*)(ws + WS_Y); \
    bf16* ACTb = (bf16*)(ws + WS_ACT); bf16* KSH = (bf16*)(ws + WS_KSH); bf16* VSH = (bf16*)(ws + WS_VSH);
    DEF_BUFS
    const float* NORMG = args.in[I_NORMG];
    bf16* XB = (bf16*)(ws + WS_XB);

#if PHSEL(0)
    if (IN(0)) { for (int rep = 0; rep < NREP(0); ++rep) { p0_prologue(F, args); __syncthreads(); } SEAM(0); }
#endif
#if PHSEL(1)
    if (IN(1)) { norm_phase<false, true>(F, args.in[I_X], nullptr, nullptr, nullptr, nullptr, NORMG + 0, MODV + 0 * D_, MODV + 1 * D_, Hb, nullptr, nullptr, nullptr, nullptr); GSEAM(1); }
#endif

    for (int L = 0; L < NLAYER; ++L) {
        const int pb = 2 + 8 * L;
#define RETID() do { const int t_ = mk_tid(wave_s); F.tid = t_; F.lane = t_ & 63; F.wave = wave_s; } while (0)
        RETID();
        int bx_ = (int)blockIdx.x; asm volatile("" : "+s"(bx_));
        { GAS unsigned char* w_ = (GAS unsigned char*)args.ws; asm volatile("" : "+s"(w_)); ws = (unsigned char*)w_; F.ws = ws; }
        DEF_BUFS
        bf16* XB = (bf16*)(ws + WS_XB);
        const float* modL = MODV + (size_t)L * 4 * 12288;
        if (IN(pb + 0)) {
            RETID();
            if (L < 2) {
#if PHSEL(2)
                pg8::Gemm g{Hb, (const bf16*)(ws + WS_WAIN + L * SZ_WAIN), M_, NPROJ, D_}; pg8::StaticOrder S; S.init(M_, NPROJ, F.G, bx_);
                pg8::EpiNsaProj E{Qb, KV6, (const float*)(ws + WS_ROPE)};
                for (int rep = 0; rep < NREP(2); ++rep) pg8::gemm_phase<pg8::EpiNsaProj, pg8::StaticOrder, true, true>(F.lds, g, S, E, F.tid);
#endif

            } else {
#if PHSEL(3)
                { pg8::Gemm g{Hb, (const bf16*)(ws + WS_WBQ + (L - 2) * SZ_WSQ), M_, D_, D_}; pg8::StaticOrder S; S.init(M_, D_, F.G, bx_);
                  pg8::EpiBf16<0> E{Qb, D_, nullptr, 0, 0, 1.f};
                  for (int rep = 0; rep < NREP(3); ++rep) pg8::gemm_phase<pg8::EpiBf16<0>, pg8::StaticOrder, true, true>(F.lds, g, S, E, F.tid); }
                if (L == 2) {
                  __syncthreads();
                  pg8::Gemm g{HKb, (const bf16*)(ws + WS_WKV), M_, 2 * D_, D_}; pg8::StaticOrder S; S.init(M_, 2 * D_, F.G, bx_);
                  pg8::EpiBf16<0> E{KSH, D_, nullptr, D_, (size_t)(WS_VSH - WS_KSH) / 2, 1.f};
                  for (int rep = 0; rep < NREP(3); ++rep) pg8::gemm_phase<pg8::EpiBf16<0>, pg8::StaticOrder, true, true>(F.lds, g, S, E, F.tid); }
#endif
            }

            SEAM(pb + 0);
        }
        if (L < 2 && IN(pb + 1)) {
            RETID();
#if PHSEL(4)
            gate_phase(F, Hb, (const bf16*)(ws + WS_WG + L * SZ_WG), args.in[I_AGATEB] + L * 48, GATES);
            for (int rep = 0; rep < NREP(4); ++rep) compress_phase(F, KV6, (const bf16*)(ws + WS_WC1 + (size_t)(2 * L) * SZ_WC1), (const bf16*)(ws + WS_WC2 + (size_t)(2 * L) * SZ_WC2), (const float*)(ws + WS_PEB) + L * 512, KCMP);
#endif

            SEAM(pb + 1);
        }
        if (IN(pb + 2)) {
            RETID();
            if (L < 2) {
#if PHSEL(5)
                for (int rep = 0; rep < NREP(5); ++rep) nsa_attn_phase(F, Qb, KV6, KCMP, GATES, Ob, (float*)(ws + WS_STASH));
#endif
            } else {
#if PHSEL(6)
                for (int rep = 0; rep < NREP(6); ++rep) sb_attn_phase(F, Qb, KSH, VSH, Ob);
#endif
            }
            SEAM(pb + 2);
        }
        if (IN(pb + 3)) {
            RETID();
            const bf16* wo = (L < 2) ? (const bf16*)(ws + WS_WAOUT + L * SZ_WSQ) : (const bf16*)(ws + WS_WBOUT + (L - 2) * SZ_WSQ);
#if PHSEL(7)
            pg8::Gemm g{Ob, wo, M_, D_, D_}; pg8::StaticOrder S; S.init(M_, D_, F.G, bx_);
            pg8::EpiBf16<0> E{Yb, D_, nullptr, 0, 0, 1.f};
            for (int rep = 0; rep < NREP(7); ++rep) pg8::gemm_phase<pg8::EpiBf16<0>, pg8::StaticOrder, true, true>(F.lds, g, S, E, F.tid);
#endif

            GSEAM(pb + 3);
        }
        if (IN(pb + 4)) {
            RETID();
#if PHSEL(1)
            if (L == 0) norm_phase<false, true>(F, args.in[I_X], Yb, modL + 2 * D_, NORMG + (size_t)(L * 4 + 1) * D_, XB, NORMG + (size_t)(L * 4 + 2) * D_, modL + 3 * D_, modL + 4 * D_, Hb, nullptr, nullptr, nullptr, nullptr);
            else norm_phase<true, true>(F, XB, Yb, modL + 2 * D_, NORMG + (size_t)(L * 4 + 1) * D_, XB, NORMG + (size_t)(L * 4 + 2) * D_, modL + 3 * D_, modL + 4 * D_, Hb, nullptr, nullptr, nullptr, nullptr);
#endif

            GSEAM(pb + 4);
        }
        if (IN(pb + 5)) {
            RETID();
#if PHSEL(8)
            pg8::Gemm g{Hb, (const bf16*)(ws + WS_WFIN + L * SZ_WFIN), M_, 2 * DFF, D_}; pg8::StaticOrder S; S.init(M_, 2 * DFF, F.G, bx_);
            pg8::EpiSwiglu E{ACTb, DFF};
            for (int rep = 0; rep < NREP(8); ++rep) pg8::gemm_phase<pg8::EpiSwiglu, pg8::StaticOrder, true, true>(F.lds, g, S, E, F.tid);
#endif

            GSEAM(pb + 5);
        }
        if (IN(pb + 6)) {
            RETID();
#if PHSEL(9)
            pg8::Gemm g{ACTb, (const bf16*)(ws + WS_WFOUT + L * SZ_WFOUT), M_, D_, DFF}; pg8::StaticOrder S; S.init(M_, D_, F.G, bx_);
            pg8::EpiBf16<0> E{Yb, D_, nullptr, 0, 0, 1.f};
            for (int rep = 0; rep < NREP(9); ++rep) pg8::gemm_phase<pg8::EpiBf16<0>, pg8::StaticOrder, true, true>(F.lds, g, S, E, F.tid);
#endif

            GSEAM(pb + 6);
        }
        if (IN(pb + 7)) {
            RETID();
            const float* modN = MODV + (size_t)(L + 1) * 4 * 12288;
            const bool nx = L + 1 < NLAYER, kv = (L == 1);
#if PHSEL(1)
            if (nx) norm_phase<true, true>(F, XB, Yb, modL + 5 * D_, NORMG + (size_t)(L * 4 + 3) * D_, XB,
                       NORMG + (size_t)((L + 1) * 4 + 0) * D_, modN + 0 * D_, modN + 1 * D_, Hb,
                       kv ? args.in[I_KVNG] : nullptr, kv ? KVMOD : nullptr, kv ? KVMOD + D_ : nullptr, kv ? HKb : nullptr);
            else norm_phase<true, false>(F, XB, Yb, modL + 5 * D_, NORMG + (size_t)(L * 4 + 3) * D_, args.out, nullptr, nullptr, nullptr, nullptr, nullptr, nullptr, nullptr, nullptr);
#endif

            GSEAM(pb + 7);
        }
    }
#undef IN
#undef SEAM
#undef GSEAM
}


#ifndef DBG_TAP
#define DBG_TAP 0
#endif
#if DBG_TAP
__global__ void dbg_tap(Args a, int tap) {
    unsigned char* ws = a.ws; const size_t n = (size_t)M_ * D_;
    const bf16* Hb = (const bf16*)(ws + WS_H); const bf16* Qb = (const bf16*)(ws + WS_Q); const bf16* KV6 = (const bf16*)(ws + WS_KV6); const bf16* Ob = (const bf16*)(ws + WS_O);
    const float* GATES = (const float*)(ws + WS_GATES); const bf16* KCMP = (const bf16*)(ws + WS_KCMP); const float* MODV = (const float*)(ws + WS_MODV);
    const bf16* WFIN = (const bf16*)(ws + WS_WFIN); const bf16* WAIN = (const bf16*)(ws + WS_WAIN); const float* ROPE = (const float*)(ws + WS_ROPE); const float* Yb = (const float*)(ws + WS_Y);
    const bf16* ACTb = (const bf16*)(ws + WS_ACT); const bf16* KSH = (const bf16*)(ws + WS_KSH); const bf16* VSH = (const bf16*)(ws + WS_VSH);
    for (size_t i = (size_t)blockIdx.x * blockDim.x + threadIdx.x; i < n; i += (size_t)gridDim.x * blockDim.x) {
        float v = 0.f;
        if (tap & 1) v += MODV[i % (16 * 12288 + 4 * 4096 + 1024)] + bf2f(WFIN[i]) + bf2f(WAIN[i % ((size_t)NINP * D_)]) + ROPE[i % (S_ * 128)];
        if (tap & 2) v += bf2f(Hb[i]);
        if (tap & 4) v += bf2f(Qb[i]) + bf2f(KV6[i % ((size_t)6 * M_ * 512)]) + bf2f(KV6[(i + (size_t)3 * M_ * 512) % ((size_t)6 * M_ * 512)]) + GATES[i % ((size_t)M_ * 48)];
        if (tap & 8) v += bf2f(KCMP[i % ((size_t)2 * 16 * NCP * HD)]);
        if (tap & 512) { const bf16* W = (const bf16*)(ws + WS_WC1); v += bf2f(W[i % ((size_t)4 * 256 * 4096 + 4 * 128 * 256)]); }
        if (tap & 1024) { const bf16* W = (const bf16*)(ws + WS_WAOUT); v += bf2f(W[i]) + bf2f(W[i + n]) + bf2f(W[(i + 2 * n) % ((WS_WC1 - WS_WAOUT) / 2)]) + bf2f(W[(i + 3 * n) % ((WS_WC1 - WS_WAOUT) / 2)]) + bf2f(W[(i + 4 * n) % ((WS_WC1 - WS_WAOUT) / 2)]) + bf2f(W[(i + 5 * n) % ((WS_WC1 - WS_WAOUT) / 2)]); }
        if (tap & 2048) v += ((const float*)(ws + WS_ACT))[i % ((size_t)256 * 32 * 256)];
        if (tap & 16) v += bf2f(Ob[i]);
        if (tap & 32) v += Yb[i];
        if (tap & 64) v += a.out[i];
        if (tap & 128) v += bf2f(ACTb[i]) + bf2f(ACTb[i + n]);
        if (tap & 256) v += bf2f(KSH[i]) + bf2f(VSH[i]);
        if (tap & 4096) v = (v != v) ? 5000.f : ((fabsf(v) > 100.f) ? 3000.f : v);
        a.out[i] = v;
    }
}
#endif
extern "C" void kernel_launch(void* const* d_in, const int* in_sizes, int n_in, void* d_out, int out_size, void* d_ws, size_t ws_size, hipStream_t stream) {
    static int grid = 0;
    if (grid == 0) {
        if (n_in != 19 || in_sizes[0] != M_ * D_ || out_size != M_ * D_ || ws_size < WS_END) {
            fprintf(stderr, "kernel_launch: unexpected shapes: n_in %d in0 %d out %d ws %zu (need %zu); nothing launched\n", n_in, n_in > 0 ? in_sizes[0] : -1, out_size, ws_size, (size_t)WS_END); grid = -1; return; }
        int dev = 0, cus = 0, per_cu = 0;
        if (hipGetDevice(&dev) != hipSuccess || hipDeviceGetAttribute(&cus, hipDeviceAttributeMultiprocessorCount, dev) != hipSuccess) { grid = -1; return; }
        if (hipFuncSetAttribute((const void*)yoco_fwd, hipFuncAttributeMaxDynamicSharedMemorySize, LDS_BYTES) != hipSuccess) { fprintf(stderr, "kernel_launch: hipFuncSetAttribute failed\n"); grid = -1; return; }
        if (hipOccupancyMaxActiveBlocksPerMultiprocessor(&per_cu, (const void*)yoco_fwd, NTHR, LDS_BYTES) != hipSuccess || per_cu < 1)
            fprintf(stderr, "kernel_launch: note: occupancy query reports %d workgroups per CU\n", per_cu);
        (void)hipGetLastError();
        grid = cus > 256 ? 256 : cus;
    }
    if (grid < 0) return;
    if (hipMemsetAsync((char*)d_ws + WS_CTL, 0, CTL_ZERO_BYTES, stream) != hipSuccess) return;
    Args a{};
    for (int i = 0; i < 19; ++i) a.in[i] = (const float*)d_in[i];
    a.out = (float*)d_out; a.ws = (unsigned char*)d_ws; a.dbg = 0; a.pad = 0;
    for (int j = 0; j < 64; ++j) a.inv[j] = powf(10000.0f, -(float)j / 64.0f);
#if MK_MULTI
#ifndef DBG_STOP
#define DBG_STOP NPHASE
#endif
    for (int ph = 0; ph < DBG_STOP; ++ph) {
        if (ph >= 2 && ((ph - 2) & 7) == 1 && (ph - 2) / 8 >= 2) continue;
        a.ph_lo = ph; a.ph_hi = ph + 1;
        hipLaunchKernelGGL(yoco_fwd, dim3(grid), dim3(NTHR), LDS_BYTES, stream, a);
    }
#if DBG_TAP
    hipLaunchKernelGGL(dbg_tap, dim3(2048), dim3(256), 0, stream, a, (int)DBG_TAP);
#endif
#else
    a.ph_lo = 0; a.ph_hi = NPHASE;
    hipLaunchKernelGGL(yoco_fwd, dim3(grid), dim3(NTHR), LDS_BYTES, stream, a);
#endif
}
```
